# Optimizing an MI355X kernel written in HIP

```python
import math
import jax, jax.numpy as jnp
from jax import lax
import numpy as np

D_MODEL = 2048
BATCH = 1
SEQ = 8192
DEPTH = 1

CHUNK = 64
MEM_LEN = 256
GM_BLOCK = 128
GM_GROUPS = 8
GM_WIDTH = 1024
GM_GROUP_DIM = GM_WIDTH // GM_GROUPS
SB_HEADS = 8
SB_HEAD_DIM = 128
SB_WIDTH = SB_HEADS * SB_HEAD_DIM
SB_QBLOCK = 128
MIX_WIDTH = GM_WIDTH + SB_WIDTH
IN_WIDTH = 2 * GM_WIDTH + 3 * SB_WIDTH
MEM_HEADS = 4
MEM_HEAD_DIM = D_MODEL // MEM_HEADS
N_GROUPS = 8
EXPERTS_PER_GROUP = 8
N_EXPERTS = N_GROUPS * EXPERTS_PER_GROUP
TOP_K = 2
D_EXPERT = D_MODEL // 4
MOE_BLOCK = 128
DN_ALPHA = (2 * DEPTH) ** 0.25
DN_BETA = (8 * DEPTH) ** -0.25
LN_EPS = 1e-5

kernel_name = "hybrid_gmlp_stickbreak_memxattn_hmoe"


def layer_norm(x, g, b):
    xf = x.astype(jnp.float32)
    mu = jnp.mean(xf, axis=-1, keepdims=True)
    xc = xf - mu
    var = jnp.mean(xc * xc, axis=-1, keepdims=True)
    return (xc * lax.rsqrt(var + LN_EPS) * g.astype(jnp.float32) + b.astype(jnp.float32)).astype(x.dtype)


def chunked_spatial_gating(u, v, ln_g, ln_b, w_s, b_s):
    b, s, _ = u.shape
    n = s // GM_BLOCK
    vg = layer_norm(v.reshape(b, s, GM_GROUPS, GM_GROUP_DIM), ln_g, ln_b)
    vg = vg.reshape(b, n, GM_BLOCK, GM_GROUPS, GM_GROUP_DIM)
    chunk_id = jnp.arange(GM_BLOCK) // CHUNK
    mask = chunk_id[:, None] >= chunk_id[None, :]
    w = jnp.where(mask, w_s, 0)
    mixed = jnp.einsum('gts,bnsgc->bntgc', w, vg) + b_s.T[:, :, None]
    return u * mixed.reshape(b, s, GM_WIDTH)


def stick_breaking_attention(q, k, v):
    b, s, h, d = q.shape
    nq = s // SB_QBLOCK
    qf = (q.astype(jnp.float32) * (d ** -0.5)).transpose(0, 2, 1, 3)
    kf = k.astype(jnp.float32).transpose(0, 2, 1, 3)
    vf = v.astype(jnp.float32).transpose(0, 2, 1, 3)
    q_blocks = qf.reshape(b, h, nq, SB_QBLOCK, d).transpose(2, 0, 1, 3, 4)
    key_pos = jnp.arange(s)

    def block(args):
        qb, i = args
        q_pos = i * SB_QBLOCK + jnp.arange(SB_QBLOCK)
        mask = key_pos[None, :] < q_pos[:, None]
        z = jnp.einsum('bhqd,bhkd->bhqk', qb, kf)
        log_beta = jax.nn.log_sigmoid(z)
        log_stay = jnp.where(mask, log_beta - z, 0.0)
        after = lax.cumsum(log_stay, axis=3, reverse=True) - log_stay
        a = jnp.where(mask, jnp.exp(log_beta + after), 0.0)
        return jnp.einsum('bhqk,bhkd->bhqd', a, vf)

    o = lax.map(block, (q_blocks, jnp.arange(nq)))
    return o.transpose(1, 0, 3, 2, 4).reshape(b, s, h * d).astype(q.dtype)


def memory_cross_attention(h, mem, w_q, w_k, w_v, w_o):
    b, s, dm = h.shape
    m = mem.shape[1]
    q = (h @ w_q).reshape(b, s, MEM_HEADS, MEM_HEAD_DIM).astype(jnp.float32)
    k = (mem @ w_k).reshape(b, m, MEM_HEADS, MEM_HEAD_DIM).astype(jnp.float32)
    v = (mem @ w_v).reshape(b, m, MEM_HEADS, MEM_HEAD_DIM).astype(jnp.float32)
    scores = jnp.einsum('bshd,bmhd->bhsm', q, k) * (MEM_HEAD_DIM ** -0.5)
    p = jax.nn.softmax(scores, axis=-1)
    o = jnp.einsum('bhsm,bmhd->bshd', p, v).astype(h.dtype).reshape(b, s, dm)
    return o @ w_o


def hierarchical_moe(h, w_group, b_group, w_router, b_router, w1, w3, w2):
    b, s, dm = h.shape
    t = b * s
    xf = h.reshape(t, dm)
    g_logits = (xf @ w_group).astype(jnp.float32) + b_group.astype(jnp.float32)
    g_probs = jax.nn.softmax(g_logits, axis=-1)
    g_val, g_idx = lax.top_k(g_probs, 1)
    e_logits_all = jnp.einsum('td,gde->tge', xf, w_router).astype(jnp.float32) + b_router.astype(jnp.float32)
    e_logits = jnp.take_along_axis(e_logits_all, g_idx[:, :, None], axis=1)[:, 0]
    top_val, top_idx = lax.top_k(e_logits, TOP_K)
    gate = jax.nn.softmax(top_val, axis=-1) * g_val
    expert_id = g_idx * EXPERTS_PER_GROUP + top_idx

    n_assign = t * TOP_K
    flat_e = expert_id.reshape(-1)
    flat_tok = jnp.repeat(jnp.arange(t, dtype=jnp.int32), TOP_K)
    flat_gate = gate.reshape(-1)
    order = jnp.argsort(flat_e)
    se, stok, sgate = flat_e[order], flat_tok[order], flat_gate[order]
    counts = jnp.bincount(flat_e, length=N_EXPERTS)
    starts = jnp.cumsum(counts) - counts
    padded = (counts + MOE_BLOCK - 1) // MOE_BLOCK * MOE_BLOCK
    pad_ends = jnp.cumsum(padded)
    pad_starts = pad_ends - padded
    dest = pad_starts[se] + jnp.arange(n_assign) - starts[se]
    n_blocks = -(-n_assign // MOE_BLOCK) + N_EXPERTS
    n_rows = n_blocks * MOE_BLOCK
    row_tok = jnp.full((n_rows,), t, jnp.int32).at[dest].set(stok)
    row_gate = jnp.zeros((n_rows,), jnp.float32).at[dest].set(sgate)
    block_expert = jnp.minimum(
        jnp.searchsorted(pad_ends, jnp.arange(n_blocks) * MOE_BLOCK, side='right'), N_EXPERTS - 1)

    x_pad = jnp.concatenate([xf, jnp.zeros((1, dm), xf.dtype)], axis=0)
    x_rows = x_pad[row_tok].reshape(n_blocks, MOE_BLOCK, dm)

    def expert_block(args):
        xb, e = args
        hid = jax.nn.silu(xb @ w1[e]) * (xb @ w3[e])
        return hid @ w2[e]

    y_rows = lax.map(expert_block, (x_rows, block_expert)).reshape(n_rows, dm)
    y = jnp.zeros((t + 1, dm), jnp.float32).at[row_tok].add(
        y_rows.astype(jnp.float32) * row_gate[:, None])[:t]
    return y.astype(h.dtype).reshape(b, s, dm)


def setup_inputs(seed: int = 0) -> dict:
    key = jax.random.key(seed)
    ks = jax.random.split(key, 26)
    f32 = jnp.float32
    nrm = lambda k, shape, scale: jax.random.normal(k, shape, f32) * scale
    col_scale = jnp.concatenate([
        jnp.full((2 * GM_WIDTH,), DN_BETA, f32),
        jnp.ones((2 * SB_WIDTH,), f32),
        jnp.full((SB_WIDTH,), DN_BETA, f32)])
    return {
        "x": nrm(ks[0], (BATCH, SEQ, D_MODEL), 1.0),
        "mem": nrm(ks[1], (BATCH, MEM_LEN, D_MODEL), 1.0),
        "w_in": nrm(ks[2], (DEPTH, D_MODEL, IN_WIDTH), D_MODEL ** -0.5) * col_scale,
        "gm_ln_g": 1.0 + nrm(ks[3], (DEPTH, GM_GROUPS, GM_GROUP_DIM), 0.02),
        "gm_ln_b": nrm(ks[4], (DEPTH, GM_GROUPS, GM_GROUP_DIM), 0.02),
        "gm_w_s": nrm(ks[5], (DEPTH, GM_GROUPS, GM_BLOCK, GM_BLOCK), GM_BLOCK ** -0.5),
        "gm_b_s": 1.0 + nrm(ks[6], (DEPTH, GM_GROUPS, GM_BLOCK), 0.01),
        "w_mix_out": nrm(ks[7], (DEPTH, MIX_WIDTH, D_MODEL), MIX_WIDTH ** -0.5 * DN_BETA),
        "ln1_g": 1.0 + nrm(ks[8], (DEPTH, D_MODEL), 0.02),
        "ln1_b": nrm(ks[9], (DEPTH, D_MODEL), 0.02),
        "mem_w_q": nrm(ks[10], (DEPTH, D_MODEL, D_MODEL), D_MODEL ** -0.5),
        "mem_w_k": nrm(ks[11], (DEPTH, D_MODEL, D_MODEL), D_MODEL ** -0.5),
        "mem_w_v": nrm(ks[12], (DEPTH, D_MODEL, D_MODEL), D_MODEL ** -0.5 * DN_BETA),
        "mem_w_o": nrm(ks[13], (DEPTH, D_MODEL, D_MODEL), D_MODEL ** -0.5 * DN_BETA),
        "ln2_g": 1.0 + nrm(ks[14], (DEPTH, D_MODEL), 0.02),
        "ln2_b": nrm(ks[15], (DEPTH, D_MODEL), 0.02),
        "w_group": nrm(ks[16], (DEPTH, D_MODEL, N_GROUPS), D_MODEL ** -0.5),
        "b_group": nrm(ks[17], (DEPTH, N_GROUPS), 0.01),
        "w_router": nrm(ks[18], (DEPTH, N_GROUPS, D_MODEL, EXPERTS_PER_GROUP), D_MODEL ** -0.5),
        "b_router": nrm(ks[19], (DEPTH, N_GROUPS, EXPERTS_PER_GROUP), 0.01),
        "w1": nrm(ks[20], (DEPTH, N_EXPERTS, D_MODEL, D_EXPERT), D_MODEL ** -0.5 * DN_BETA),
        "w3": nrm(ks[21], (DEPTH, N_EXPERTS, D_MODEL, D_EXPERT), D_MODEL ** -0.5 * DN_BETA),
        "w2": nrm(ks[22], (DEPTH, N_EXPERTS, D_EXPERT, D_MODEL), D_EXPERT ** -0.5 * DN_BETA),
        "ln3_g": 1.0 + nrm(ks[23], (DEPTH, D_MODEL), 0.02),
        "ln3_b": nrm(ks[24], (DEPTH, D_MODEL), 0.02),
    }


def reference(x, mem, w_in, gm_ln_g, gm_ln_b, gm_w_s, gm_b_s, w_mix_out, ln1_g, ln1_b,
              mem_w_q, mem_w_k, mem_w_v, mem_w_o, ln2_g, ln2_b,
              w_group, b_group, w_router, b_router, w1, w3, w2, ln3_g, ln3_b):
    b, s, dm = x.shape
    h = x
    for l in range(DEPTH):
        proj = h @ w_in[l]
        u_a, v_a, q, k, v = jnp.split(
            proj, [GM_WIDTH, 2 * GM_WIDTH, 2 * GM_WIDTH + SB_WIDTH, 2 * GM_WIDTH + 2 * SB_WIDTH], axis=-1)
        mix_a = chunked_spatial_gating(jax.nn.gelu(u_a), jax.nn.gelu(v_a),
                                       gm_ln_g[l], gm_ln_b[l], gm_w_s[l], gm_b_s[l])
        mix_b = stick_breaking_attention(q.reshape(b, s, SB_HEADS, SB_HEAD_DIM),
                                         k.reshape(b, s, SB_HEADS, SB_HEAD_DIM),
                                         v.reshape(b, s, SB_HEADS, SB_HEAD_DIM))
        mixed = jnp.concatenate([mix_a, mix_b], axis=-1) @ w_mix_out[l]
        h = layer_norm(DN_ALPHA * h + mixed, ln1_g[l], ln1_b[l])
        h = layer_norm(DN_ALPHA * h + memory_cross_attention(h, mem, mem_w_q[l], mem_w_k[l],
                                                             mem_w_v[l], mem_w_o[l]),
                       ln2_g[l], ln2_b[l])
        h = layer_norm(DN_ALPHA * h + hierarchical_moe(h, w_group[l], b_group[l], w_router[l],
                                                       b_router[l], w1[l], w3[l], w2[l]),
                       ln3_g[l], ln3_b[l])
    return h
```

```cpp
#include <hip/hip_runtime.h>
#include <hip/hip_cooperative_groups.h>
#include <stdint.h>
#include <stdio.h>
namespace cg = cooperative_groups;

typedef unsigned short u16;
using bf16x8 = __attribute__((ext_vector_type(8))) short;
using f32x4 = __attribute__((ext_vector_type(4))) float;
using u32x4 = __attribute__((ext_vector_type(4))) unsigned int;
#define LAS __attribute__((address_space(3)))

constexpr int SEQ = 8192, DM = 2048, INW = 5120, MEML = 256;
constexpr int NEXP = 64, DEXP = 512;
constexpr float DN_ALPHA = 1.189207115002721f;
constexpr float SB_THRESH = 40.f;
constexpr int LDS_BYTES = 73728;
constexpr size_t MB = 1u << 20;

struct Params {
  const float *x, *mem, *w_in, *gm_ln_g, *gm_ln_b, *gm_w_s, *gm_b_s, *w_mix_out, *ln1_g, *ln1_b;
  const float *mem_w_q, *mem_w_k, *mem_w_v, *mem_w_o, *ln2_g, *ln2_b, *w_group, *b_group, *w_router, *b_router;
  const float *w1, *w3, *w2, *ln3_g, *ln3_b;
  float* out;
  char* ws;
#define WSP(T, name, offmb) __device__ __forceinline__ T* name() const { return (T*)(ws + (size_t)(offmb) * MB); }
  WSP(u16, WinT, 0) WSP(u16, WmixT, 20) WSP(u16, WqT, 28) WSP(u16, WkT, 36) WSP(u16, WvT, 44) WSP(u16, WoT, 52)
  WSP(u16, W1T, 60) WSP(u16, W3T, 188) WSP(u16, W2T, 316)
  WSP(u16, xb, 444)
  WSP(float, scores, 444)
  WSP(u16, memb, 476) WSP(u16, kmem, 477) WSP(u16, vmemT, 478)
  WSP(u16, proj, 479)
  WSP(u16, qm, 479)
  WSP(u16, om, 511)
  WSP(u16, yslot, 479)
  WSP(u16, mixcat, 559)
  WSP(u16, Pm, 559)
  WSP(u16, hid, 575)
  WSP(float, pre, 591)
  WSP(float, hf, 655)
  WSP(u16, hb, 719)
  WSP(int, cnt, 751)
  __device__ __forceinline__ float* gates() const { return (float*)(ws + 751 * MB + 65536); }
  WSP(int, rowlist, 752)
  WSP(unsigned, bar, 754)
  WSP(float, wgT, 755)
  __device__ __forceinline__ float* wrT() const { return (float*)(ws + 755 * MB + 65536); }
};

__device__ __forceinline__ uint32_t pack2(float a, float b);
__device__ __forceinline__ u16 f2bf(float f) { return (u16)(pack2(f, f) & 0xffffu); }
__device__ __forceinline__ float bflo(uint32_t w) { return __uint_as_float(w << 16); }
__device__ __forceinline__ float bfhi(uint32_t w) { return __uint_as_float(w & 0xffff0000u); }
typedef float f32x2_t __attribute__((ext_vector_type(2)));
typedef __bf16 bf16x2_t __attribute__((ext_vector_type(2)));
__device__ __forceinline__ uint32_t pack2(float a, float b) {
  f32x2_t v = {a, b};
  bf16x2_t r = __builtin_convertvector(v, bf16x2_t);
  return __builtin_bit_cast(uint32_t, r);
}
__device__ __forceinline__ float gelu_tanh(float x) {
  float u = 0.7978845608028654f * (x + 0.044715f * x * x * x);
  float e = __expf(2.f * u);
  float th = 1.f - 2.f / (e + 1.f);
  return 0.5f * x * (1.f + th);
}
__device__ __forceinline__ float wave_sum(float v) {
#pragma unroll
  for (int o = 32; o; o >>= 1) v += __shfl_xor(v, o);
  return v;
}
__device__ __forceinline__ float wave_max(float v) {
#pragma unroll
  for (int o = 32; o; o >>= 1) v = fmaxf(v, __shfl_xor(v, o));
  return v;
}
__device__ __forceinline__ void store_bf4(u16* dst, float a, float b, float c, float d) {
  uint2 w; w.x = pack2(a, b); w.y = pack2(c, d);
  *(uint2*)dst = w;
}

__device__ __forceinline__ void mma_128x128x64(const u16* sA, const u16* sB, f32x4 (&acc)[4][4], int wr, int wc, int fr, int fq) {
#pragma unroll
  for (int ks = 0; ks < 2; ks++) {
    bf16x8 af[4], bfr[4];
#pragma unroll
    for (int mt = 0; mt < 4; mt++) {
      int row = wr * 64 + mt * 16 + fr;
      int ch = (ks * 4 + fq) ^ ((row >> 1) & 7);
      af[mt] = *(const bf16x8*)(sA + row * 64 + ch * 8);
    }
#pragma unroll
    for (int nt = 0; nt < 4; nt++) {
      int row = wc * 64 + nt * 16 + fr;
      int ch = (ks * 4 + fq) ^ ((row >> 1) & 7);
      bfr[nt] = *(const bf16x8*)(sB + row * 64 + ch * 8);
    }
    __builtin_amdgcn_s_setprio(1);
#pragma unroll
    for (int mt = 0; mt < 4; mt++)
#pragma unroll
      for (int nt = 0; nt < 4; nt++)
        acc[mt][nt] = __builtin_amdgcn_mfma_f32_16x16x32_bf16(bfr[nt], af[mt], acc[mt][nt], 0, 0, 0);
    __builtin_amdgcn_s_setprio(0);
  }
}

template <class BP, class Epi>
__device__ __forceinline__ void gemm_tile(const u16* __restrict__ A, long lda, const int* arow, int m0, BP bptr, int K,
                                          u16* smem, Epi epi) {
  const int t = threadIdx.x, lane = t & 63, wid = t >> 6, wr = wid >> 1, wc = wid & 1, fr = lane & 15, fq = lane >> 4;
  const int lr = t >> 3;
  const int gch = ((t & 7) ^ ((t >> 4) & 7)) << 3;
  const u16 *ap0, *ap1, *ap2, *ap3;
  {
    long g0 = arow ? (long)arow[lr] : (long)(m0 + lr);
    long g1 = arow ? (long)arow[lr + 32] : (long)(m0 + lr + 32);
    long g2 = arow ? (long)arow[lr + 64] : (long)(m0 + lr + 64);
    long g3 = arow ? (long)arow[lr + 96] : (long)(m0 + lr + 96);
    ap0 = A + g0 * lda + gch; ap1 = A + g1 * lda + gch; ap2 = A + g2 * lda + gch; ap3 = A + g3 * lda + gch;
  }
  const u16* bp0 = bptr(lr) + gch;
  const u16* bp1 = bptr(lr + 32) + gch;
  const u16* bp2 = bptr(lr + 64) + gch;
  const u16* bp3 = bptr(lr + 96) + gch;
  f32x4 acc[4][4];
#pragma unroll
  for (int i = 0; i < 4; i++)
#pragma unroll
    for (int j = 0; j < 4; j++) acc[i][j] = f32x4{0.f, 0.f, 0.f, 0.f};
#define GLDS(src, dst) __builtin_amdgcn_global_load_lds((const unsigned*)(src), (unsigned*)(dst), 16, 0, 0)
#define STAGE(k0, buf)                                                          \
  {                                                                             \
    u16* dA = smem + (buf) * 16384 + wid * 512;                                 \
    u16* dB = dA + 8192;                                                        \
    GLDS(ap0 + (k0), dA); GLDS(bp0 + (k0), dB);                                 \
    GLDS(ap1 + (k0), dA + 2048); GLDS(bp1 + (k0), dB + 2048);                   \
    GLDS(ap2 + (k0), dA + 4096); GLDS(bp2 + (k0), dB + 4096);                   \
    GLDS(ap3 + (k0), dA + 6144); GLDS(bp3 + (k0), dB + 6144);                   \
  }
  STAGE(0, 0);
  const int nk = K >> 6;
  for (int kt = 0; kt < nk; kt++) {
    asm volatile("s_waitcnt vmcnt(0)" ::: "memory");
    __syncthreads();
    if (kt + 1 < nk) STAGE((kt + 1) << 6, (kt + 1) & 1);
    const u16* sA = smem + (kt & 1) * 16384;
    mma_128x128x64(sA, sA + 8192, acc, wr, wc, fr, fq);
  }
#undef STAGE
#undef GLDS
#pragma unroll
  for (int mt = 0; mt < 4; mt++) epi(wr * 64 + mt * 16 + fr, wc * 64 + fq * 4, acc[mt]);
}

struct TileDesc { const u16* A; const u16* B; int m0; };
template <class Desc, class Epi>
__device__ __forceinline__ void gemm_stream(int total, long lda, long ldb, int K, u16* smem, Desc desc, Epi epi) {
  const int t = threadIdx.x, lane = t & 63, wid = t >> 6, wr = wid >> 1, wc = wid & 1, fr = lane & 15, fq = lane >> 4;
  const int lr = t >> 3;
  const int gch = ((t & 7) ^ ((t >> 4) & 7)) << 3;
  int j = blockIdx.x;
  if (j >= total) return;
  const u16 *ap, *bp;
  const long as32 = 32 * lda, bs32 = 32 * ldb;
#define SETUP(jj)                                                               \
  {                                                                             \
    TileDesc d_ = desc(jj);                                                     \
    ap = d_.A + (long)(d_.m0 + lr) * lda + gch;                                 \
    bp = d_.B + (long)lr * ldb + gch;                                           \
  }
#define GLDS(src, dst) __builtin_amdgcn_global_load_lds((const unsigned*)(src), (unsigned*)(dst), 16, 0, 0)
#define STAGE(k0, buf)                                                          \
  {                                                                             \
    u16* dA = smem + (buf) * 16384 + wid * 512;                                 \
    u16* dB = dA + 8192;                                                        \
    GLDS(ap + (k0), dA); GLDS(bp + (k0), dB);                                   \
    GLDS(ap + as32 + (k0), dA + 2048); GLDS(bp + bs32 + (k0), dB + 2048);       \
    GLDS(ap + 2 * as32 + (k0), dA + 4096); GLDS(bp + 2 * bs32 + (k0), dB + 4096); \
    GLDS(ap + 3 * as32 + (k0), dA + 6144); GLDS(bp + 3 * bs32 + (k0), dB + 6144); \
  }
  SETUP(j);
  STAGE(0, 0);
  const int nk = K >> 6;
  for (;;) {
    f32x4 acc[4][4];
#pragma unroll
    for (int i = 0; i < 4; i++)
#pragma unroll
      for (int q = 0; q < 4; q++) acc[i][q] = f32x4{0.f, 0.f, 0.f, 0.f};
    for (int kt = 0; kt < nk; kt++) {
      asm volatile("s_waitcnt vmcnt(0)" ::: "memory");
      __syncthreads();
      if (kt + 1 < nk) STAGE((kt + 1) << 6, (kt + 1) & 1);
      const u16* sA = smem + (kt & 1) * 16384;
      mma_128x128x64(sA, sA + 8192, acc, wr, wc, fr, fq);
    }
    const int jn = j + gridDim.x;
    const bool has = jn < total;
    if (has) { SETUP(jn); STAGE(0, 0); }
#pragma unroll
    for (int mt = 0; mt < 4; mt++) epi(j, wr * 64 + mt * 16 + fr, wc * 64 + fq * 4, acc[mt]);
    if (!has) break;
    j = jn;
  }
#undef SETUP
#undef STAGE
#undef GLDS
}

typedef short s16x4 __attribute__((ext_vector_type(4)));
__device__ __forceinline__ int wt_off(int k, int ch) { return 256 * k + 16 * (ch ^ (((k & 3) << 2) | ((k >> 2) & 3))); }

template <class WM, class Epi>
__device__ __forceinline__ void gemm_tile_wf32(const u16* __restrict__ A, long lda, const int* arow, WM wmap, long kstride, int K,
                                               u16* smem, Epi epi) {
  const int t = threadIdx.x, lane = t & 63, wid = t >> 6, wr = wid >> 1, wc = wid & 1, fr = lane & 15, fq = lane >> 4;
  const int lr = t >> 3;
  const int gch = ((t & 7) ^ ((t >> 4) & 7)) << 3;
  const unsigned ao0 = (unsigned)(arow[lr] * (int)lda + gch), ao1 = (unsigned)(arow[lr + 32] * (int)lda + gch);
  const unsigned ao2 = (unsigned)(arow[lr + 64] * (int)lda + gch), ao3 = (unsigned)(arow[lr + 96] * (int)lda + gch);
  const float* wp0;
  int woff0, woff1;
  {
    int kw, vw;
    wmap(kw, vw, wp0);
    woff0 = wt_off(kw, vw >> 3) + ((vw >> 2) & 1) * 8;
    woff1 = wt_off(kw + 8, vw >> 3) + ((vw >> 2) & 1) * 8;
  }
  f32x4 acc[4][4];
#pragma unroll
  for (int i = 0; i < 4; i++)
#pragma unroll
    for (int j = 0; j < 4; j++) acc[i][j] = f32x4{0.f, 0.f, 0.f, 0.f};
  f32x4 wr0[8], wr1[8];
#define GLDS(src, dst) __builtin_amdgcn_global_load_lds((const unsigned*)(src), (unsigned*)(dst), 16, 0, 0)
#define STAGE_A(k0, buf)                                                        \
  {                                                                             \
    u16* dA = smem + (buf) * 16384 + wid * 512;                                 \
    const u16* Ak = A + (k0);                                                   \
    GLDS(Ak + ao0, dA); GLDS(Ak + ao1, dA + 2048);                              \
    GLDS(Ak + ao2, dA + 4096); GLDS(Ak + ao3, dA + 6144);                       \
  }
#define LOAD_W(R, k0)                                                           \
  {                                                                             \
    _Pragma("unroll") for (int i = 0; i < 8; i++) R[i] = *(const f32x4*)(wp0 + (long)((k0) + 8 * i) * kstride); \
  }
#define WRITE_W(R, buf)                                                         \
  {                                                                             \
    char* dB = (char*)(smem + (buf) * 16384 + 8192);                            \
    _Pragma("unroll") for (int i = 0; i < 8; i++) {                             \
      uint2 w2; w2.x = pack2(R[i][0], R[i][1]); w2.y = pack2(R[i][2], R[i][3]); \
      *(uint2*)(dB + ((i & 1) ? woff1 : woff0) + 2048 * (i & ~1)) = w2;                                             \
    }                                                                           \
  }
#define COMPUTE(buf)                                                            \
  {                                                                             \
    const u16* sA = smem + (buf) * 16384;                                       \
    const char* sB = (const char*)(sA + 8192);                                  \
    _Pragma("unroll") for (int ks = 0; ks < 2; ks++) {                          \
      bf16x8 af[4], bfr[4];                                                     \
      _Pragma("unroll") for (int mt = 0; mt < 4; mt++) {                        \
        int row = wr * 64 + mt * 16 + fr;                                       \
        int ch = (ks * 4 + fq) ^ ((row >> 1) & 7);                              \
        af[mt] = *(const bf16x8*)(sA + row * 64 + ch * 8);                      \
      }                                                                         \
      _Pragma("unroll") for (int nt = 0; nt < 4; nt++) {                        \
        const int c0 = (wc * 64 + nt * 16) >> 3;                                \
        const int k0_ = ks * 32 + fq * 8 + tq;                                  \
        s16x4 lo = __builtin_amdgcn_ds_read_tr16_b64_v4i16((s16x4 LAS*)(sB + wt_off(k0_, c0 + (tp >> 1)) + 8 * (tp & 1)));     \
        s16x4 hi = __builtin_amdgcn_ds_read_tr16_b64_v4i16((s16x4 LAS*)(sB + wt_off(k0_ + 4, c0 + (tp >> 1)) + 8 * (tp & 1))); \
        bfr[nt] = bf16x8{lo[0], lo[1], lo[2], lo[3], hi[0], hi[1], hi[2], hi[3]}; \
      }                                                                         \
      _Pragma("unroll") for (int mt = 0; mt < 4; mt++)                          \
        _Pragma("unroll") for (int nt = 0; nt < 4; nt++)                        \
          acc[mt][nt] = __builtin_amdgcn_mfma_f32_16x16x32_bf16(bfr[nt], af[mt], acc[mt][nt], 0, 0, 0); \
    }                                                                           \
  }
  const int tq = fr >> 2, tp = fr & 3;
  const int trb = wt_off(fq * 8 + tq, wc * 8 + (tp >> 1)) + 8 * (tp & 1);
  const int nk = K >> 6;
  STAGE_A(0, 0);
  LOAD_W(wr0, 0);
  LOAD_W(wr1, 64);
  WRITE_W(wr0, 0);
  for (int kt = 0; kt < nk; kt += 2) {
    asm volatile("s_waitcnt vmcnt(8)" ::: "memory");
    __syncthreads();
    STAGE_A((kt + 1) << 6, 1);
    if (kt + 2 < nk) LOAD_W(wr0, (kt + 2) << 6);
    COMPUTE(0);
    WRITE_W(wr1, 1);
    if (kt + 2 < nk) { asm volatile("s_waitcnt vmcnt(8)" ::: "memory"); } else { asm volatile("s_waitcnt vmcnt(0)" ::: "memory"); }
    __syncthreads();
    if (kt + 2 < nk) { STAGE_A((kt + 2) << 6, 0); }
    if (kt + 3 < nk) LOAD_W(wr1, (kt + 3) << 6);
    COMPUTE(1);
    if (kt + 2 < nk) WRITE_W(wr0, 0);
  }
#undef STAGE_A
#undef LOAD_W
#undef WRITE_W
#undef COMPUTE
#undef GLDS
#pragma unroll
  for (int mt = 0; mt < 4; mt++) epi(wr * 64 + mt * 16 + fr, wc * 64 + fq * 4, acc[mt]);
}

__device__ __forceinline__ void transpose_tile(const float* __restrict__ src, u16* __restrict__ dst, int R, int C, int tr, int tc, u16* lds) {
  const int t = threadIdx.x;
#pragma unroll
  for (int i = 0; i < 4; i++) {
    int r = (t >> 4) + 16 * i, c4 = (t & 15) * 4;
    float4 v = *(const float4*)(src + (long)(tr * 64 + r) * C + tc * 64 + c4);
    lds[(c4 + 0) * 66 + r] = f2bf(v.x);
    lds[(c4 + 1) * 66 + r] = f2bf(v.y);
    lds[(c4 + 2) * 66 + r] = f2bf(v.z);
    lds[(c4 + 3) * 66 + r] = f2bf(v.w);
  }
  __syncthreads();
  {
    int n = t >> 2, k0 = (t & 3) * 16;
    const uint32_t* s32 = (const uint32_t*)(lds + n * 66 + k0);
    uint4 a, b;
    a.x = s32[0]; a.y = s32[1]; a.z = s32[2]; a.w = s32[3];
    b.x = s32[4]; b.y = s32[5]; b.z = s32[6]; b.w = s32[7];
    u16* d = dst + (long)(tc * 64 + n) * R + tr * 64 + k0;
    *(uint4*)d = a;
    *(uint4*)(d + 8) = b;
  }
  __syncthreads();
}

__device__ void phase_convert(const Params& p, u16* smem) {
  const int nb = gridDim.x, bid = blockIdx.x, t = threadIdx.x;
  if (bid == 0 && t < NEXP) p.cnt()[t * 32] = 0;
  for (int i = bid * 256 + t; i < 9 * 8 * DM; i += nb * 256) {
    int G = i / (8 * DM), rem = i % (8 * DM), e = rem / DM, d = rem % DM;
    if (G == 0) p.wgT()[e * DM + d] = p.w_group[d * 8 + e];
    else p.wrT()[((G - 1) * 8 + e) * DM + d] = p.w_router[((long)(G - 1) * DM + d) * 8 + e];
  }
  {
    const long n4x = (long)SEQ * DM / 4, n4m = (long)MEML * DM / 4;
    for (long i = (long)bid * 256 + t; i < n4x + n4m; i += (long)nb * 256) {
      const float* s; u16* d; long j;
      if (i < n4x) { s = p.x; d = p.xb(); j = i; } else { s = p.mem; d = p.memb(); j = i - n4x; }
      float4 v = *(const float4*)(s + j * 4);
      store_bf4(d + j * 4, v.x, v.y, v.z, v.w);
    }
  }
  const int T_IN = 2560, T_SQ = 1024;
  const int total = T_IN + 5 * T_SQ;
  for (int j = bid; j < total; j += nb) {
    const float* src; u16* dst; int R, C, tl;
    if (j < T_IN) { src = p.w_in; dst = p.WinT(); R = DM; C = INW; tl = j; }
    else {
      int q = (j - T_IN) / T_SQ; tl = (j - T_IN) % T_SQ; R = DM; C = DM;
      src = q == 0 ? p.w_mix_out : q == 1 ? p.mem_w_q : q == 2 ? p.mem_w_k : q == 3 ? p.mem_w_v : p.mem_w_o;
      dst = q == 0 ? p.WmixT() : q == 1 ? p.WqT() : q == 2 ? p.WkT() : q == 3 ? p.WvT() : p.WoT();
    }
    int ntc = C / 64;
    transpose_tile(src, dst, R, C, tl / ntc, tl % ntc, smem);
  }
}

__device__ void phase_inproj(const Params& p, u16* smem) {
  const int MT = SEQ / 128, NT = INW / 128;
  const u16* xb = p.xb(); const u16* WinT = p.WinT(); u16* proj = p.proj();
  gemm_stream(MT * NT, DM, DM, DM, smem,
              [&](int j) { int mt = j % MT, nt = j / MT; TileDesc d; d.A = xb; d.B = WinT + (long)nt * 128 * DM; d.m0 = mt * 128; return d; },
              [&](int j, int m, int nb, f32x4 (&a)[4]) {
                int mt = j % MT, nt = j / MT;
                int seg = nt >> 3;
                u16* outp = proj + (long)(mt * 128 + m) * INW + nt * 128 + nb;
#pragma unroll
                for (int q = 0; q < 4; q++) {
                  float v0 = a[q][0], v1 = a[q][1], v2 = a[q][2], v3 = a[q][3];
                  if (seg < 2) { v0 = gelu_tanh(v0); v1 = gelu_tanh(v1); v2 = gelu_tanh(v2); v3 = gelu_tanh(v3); }
                  else if (seg == 2) { const float sc = 0.08838834764831845f; v0 *= sc; v1 *= sc; v2 *= sc; v3 *= sc; }
                  store_bf4(outp + q * 16, v0, v1, v2, v3);
                }
              });
}

__device__ void memkv_tile(const Params& p, int jj, u16* smem) {
  int which = jj / 32, r_ = jj % 32, mt = r_ & 1, nt = r_ >> 1;
  const u16* W = (which == 0 ? p.WkT() : p.WvT()) + (long)nt * 128 * DM;
  u16* outk = p.kmem() + (long)mt * 128 * DM + nt * 128;
  u16* outv = p.vmemT() + (long)nt * 128 * MEML + mt * 128;
  gemm_tile(p.memb(), DM, nullptr, mt * 128, [&](int r) { return W + (long)r * DM; }, DM, smem,
            [&](int m, int nb, f32x4 (&a)[4]) {
#pragma unroll
              for (int q = 0; q < 4; q++) {
                if (which == 0) store_bf4(outk + (long)m * DM + nb + q * 16, a[q][0], a[q][1], a[q][2], a[q][3]);
                else {
#pragma unroll
                  for (int e = 0; e < 4; e++) outv[(long)(nb + q * 16 + e) * MEML + m] = f2bf(a[q][e]);
                }
              }
            });
  __syncthreads();
}

__device__ void gmlp_item(const Params& p, int nb, int g, u16* smem) {
  const int t = threadIdx.x, lane = t & 63, wid = t >> 6, wr = wid >> 1, wc = wid & 1, fr = lane & 15, fq = lane >> 4;
  u16* sA = smem;
  u16* sB = smem + 16384;
#pragma unroll
  for (int i = 0; i < 8; i++) {
    int q = t + 256 * i;
    int tt = q >> 4, sc = q & 15, kt = sc >> 3, c = sc & 7;
    const float* src = p.gm_w_s + ((long)g * 128 + tt) * 128 + sc * 8;
    float4 a = *(const float4*)src, b = *(const float4*)(src + 4);
    bool keep = (tt >> 6) >= kt;
    uint4 w;
    w.x = keep ? pack2(a.x, a.y) : 0u; w.y = keep ? pack2(a.z, a.w) : 0u;
    w.z = keep ? pack2(b.x, b.y) : 0u; w.w = keep ? pack2(b.z, b.w) : 0u;
    *(uint4*)(sA + kt * 8192 + tt * 64 + ((c ^ ((tt >> 1) & 7)) << 3)) = w;
  }
  {
    const int s = t >> 1, half = t & 1;
    const u16* vp = p.proj() + (long)(nb * 128 + s) * INW + 1024 + g * 128 + half * 64;
    float v[64];
#pragma unroll
    for (int i = 0; i < 8; i++) {
      uint4 w = *(const uint4*)(vp + i * 8);
      v[i * 8 + 0] = bflo(w.x); v[i * 8 + 1] = bfhi(w.x); v[i * 8 + 2] = bflo(w.y); v[i * 8 + 3] = bfhi(w.y);
      v[i * 8 + 4] = bflo(w.z); v[i * 8 + 5] = bfhi(w.z); v[i * 8 + 6] = bflo(w.w); v[i * 8 + 7] = bfhi(w.w);
    }
    float sum = 0.f;
#pragma unroll
    for (int i = 0; i < 64; i++) sum += v[i];
    sum += __shfl_xor(sum, 1);
    const float mean = sum * (1.f / 128.f);
    float sq = 0.f;
#pragma unroll
    for (int i = 0; i < 64; i++) { float d = v[i] - mean; sq += d * d; }
    sq += __shfl_xor(sq, 1);
    const float rstd = rsqrtf(sq * (1.f / 128.f) + 1e-5f);
    const int kt = s >> 6, kk = s & 63;
    const float* lg = p.gm_ln_g + g * 128 + half * 64;
    const float* lb = p.gm_ln_b + g * 128 + half * 64;
#pragma unroll
    for (int i = 0; i < 64; i++) {
      int cc = half * 64 + i;
      float val = (v[i] - mean) * rstd * lg[i] + lb[i];
      sB[kt * 8192 + cc * 64 + (((kk >> 3) ^ ((cc >> 1) & 7)) << 3) + (kk & 7)] = f2bf(val);
    }
  }
  __syncthreads();
  f32x4 acc[4][4];
#pragma unroll
  for (int i = 0; i < 4; i++)
#pragma unroll
    for (int j = 0; j < 4; j++) acc[i][j] = f32x4{0.f, 0.f, 0.f, 0.f};
  mma_128x128x64(sA, sB, acc, wr, wc, fr, fq);
  mma_128x128x64(sA + 8192, sB + 8192, acc, wr, wc, fr, fq);
#pragma unroll
  for (int mt = 0; mt < 4; mt++) {
    int m = wr * 64 + mt * 16 + fr;
    float bs = p.gm_b_s[g * 128 + m];
    const u16* up = p.proj() + (long)(nb * 128 + m) * INW + g * 128;
    u16* op = p.mixcat() + (long)(nb * 128 + m) * DM + g * 128;
#pragma unroll
    for (int nt = 0; nt < 4; nt++) {
      int n = wc * 64 + nt * 16 + fq * 4;
      uint2 uw = *(const uint2*)(up + n);
      f32x4 a = acc[mt][nt];
      store_bf4(op + n, bflo(uw.x) * (a[0] + bs), bfhi(uw.x) * (a[1] + bs), bflo(uw.y) * (a[2] + bs), bfhi(uw.y) * (a[3] + bs));
    }
  }
  __syncthreads();
}

__device__ void attn_item(const Params& p, int h, int qt, u16* smem) {
  u16* sK = smem;
  u16* sP = smem;
  u16* sVt = smem + 8192;
  float* sS = (float*)(smem + 16384);
  const int t = threadIdx.x, lane = t & 63, w = t >> 6, fr = lane & 15, fq = lane >> 4;
  const int q0 = qt * 128;
  const u16* Qb = p.proj() + 2048 + h * 128;
  const u16* Kb = p.proj() + 3072 + h * 128;
  const u16* Vb = p.proj() + 4096 + h * 128;
  f32x4 o[2][8];
#pragma unroll
  for (int i = 0; i < 2; i++)
#pragma unroll
    for (int j = 0; j < 8; j++) o[i][j] = f32x4{0.f, 0.f, 0.f, 0.f};
  const int srow = t >> 1, half = t & 1;
  const int qg = q0 + srow;
  float crow = 0.f;
  for (int kb = qt * 2 + 1; kb >= 0; kb--) {
    bf16x8 qf[2][4];
#pragma unroll
    for (int mt = 0; mt < 2; mt++)
#pragma unroll
      for (int ks = 0; ks < 4; ks++)
        qf[mt][ks] = *(const bf16x8*)(Qb + (long)(q0 + w * 32 + mt * 16 + fr) * INW + ks * 32 + fq * 8);
#pragma unroll
    for (int i = 0; i < 4; i++) {
      int idx = t + 256 * i;
      int key = idx >> 4, ch = idx & 15;
      uint4 kv = *(const uint4*)(Kb + (long)(kb * 64 + key) * INW + ch * 8);
      *(uint4*)(sK + key * 128 + ((ch ^ (key & 15)) << 3)) = kv;
      uint4 vv = *(const uint4*)(Vb + (long)(kb * 64 + key) * INW + ch * 8);
      uint32_t ws[4] = {vv.x, vv.y, vv.z, vv.w};
#pragma unroll
      for (int e = 0; e < 8; e++) {
        int d = ch * 8 + e;
        uint32_t wv = ws[e >> 1];
        u16 val = (e & 1) ? (u16)(wv >> 16) : (u16)(wv & 0xffffu);
        sVt[d * 64 + (((key >> 3) ^ ((d >> 1) & 7)) << 3) + (key & 7)] = val;
      }
    }
    __syncthreads();
#pragma unroll
    for (int nt = 0; nt < 4; nt++) {
      f32x4 s0 = f32x4{0.f, 0.f, 0.f, 0.f}, s1 = f32x4{0.f, 0.f, 0.f, 0.f};
      const int krow = nt * 16 + fr;
#pragma unroll
      for (int ks = 0; ks < 4; ks++) {
        bf16x8 kf = *(const bf16x8*)(sK + krow * 128 + (((ks * 4 + fq) ^ (krow & 15)) << 3));
        s0 = __builtin_amdgcn_mfma_f32_16x16x32_bf16(kf, qf[0][ks], s0, 0, 0, 0);
        s1 = __builtin_amdgcn_mfma_f32_16x16x32_bf16(kf, qf[1][ks], s1, 0, 0, 0);
      }
      *(f32x4*)(sS + (w * 32 + fr) * 68 + nt * 16 + fq * 4) = s0;
      *(f32x4*)(sS + (w * 32 + 16 + fr) * 68 + nt * 16 + fq * 4) = s1;
    }
    __syncthreads();
    {
      float z[32];
      float* srp = sS + srow * 68 + half * 32;
#pragma unroll
      for (int j4 = 0; j4 < 8; j4++) {
        f32x4 v = *(const f32x4*)(srp + j4 * 4);
        z[j4 * 4 + 0] = v[0]; z[j4 * 4 + 1] = v[1]; z[j4 * 4 + 2] = v[2]; z[j4 * 4 + 3] = v[3];
      }
      const int kbase = kb * 64 + half * 32;
      float tot = 0.f;
#pragma unroll
      for (int j4 = 0; j4 < 8; j4++) {
        f32x4 sv;
#pragma unroll
        for (int e = 0; e < 4; e++) {
          const int j = j4 * 4 + e;
          bool valid = (kbase + j) < qg;
          float zz = z[j];
          float s = valid ? (fmaxf(zz, 0.f) + __logf(1.f + __expf(-fabsf(zz)))) : 0.f;
          sv[e] = s;
          tot += s;
          z[j] = zz - s;
        }
        *(f32x4*)(srp + j4 * 4) = sv;
      }
      const float ptot = __shfl_xor(tot, 1);
      float c = crow + (half == 0 ? ptot : 0.f);
#pragma unroll
      for (int j4 = 7; j4 >= 0; j4--) {
        f32x4 sv = *(const f32x4*)(srp + j4 * 4);
#pragma unroll
        for (int e = 3; e >= 0; e--) {
          const int j = j4 * 4 + e;
          bool valid = (kbase + j) < qg;
          float a = valid ? __expf(z[j] - c) : 0.f;
          c += sv[e];
          z[j] = a;
        }
      }
      crow += tot + ptot;
#pragma unroll
      for (int q = 0; q < 4; q++) {
        uint4 wv;
        wv.x = pack2(z[q * 8 + 0], z[q * 8 + 1]); wv.y = pack2(z[q * 8 + 2], z[q * 8 + 3]);
        wv.z = pack2(z[q * 8 + 4], z[q * 8 + 5]); wv.w = pack2(z[q * 8 + 6], z[q * 8 + 7]);
        *(uint4*)(sP + srow * 64 + (((half * 4 + q) ^ ((srow >> 1) & 7)) << 3)) = wv;
      }
    }
    const int done = __syncthreads_and(crow > SB_THRESH);
#pragma unroll
    for (int ks = 0; ks < 2; ks++) {
      bf16x8 pf[2];
#pragma unroll
      for (int mt = 0; mt < 2; mt++) {
        int row = w * 32 + mt * 16 + fr;
        pf[mt] = *(const bf16x8*)(sP + row * 64 + (((ks * 4 + fq) ^ ((row >> 1) & 7)) << 3));
      }
#pragma unroll
      for (int nt = 0; nt < 8; nt++) {
        int row = nt * 16 + fr;
        bf16x8 vf = *(const bf16x8*)(sVt + row * 64 + (((ks * 4 + fq) ^ ((row >> 1) & 7)) << 3));
        o[0][nt] = __builtin_amdgcn_mfma_f32_16x16x32_bf16(vf, pf[0], o[0][nt], 0, 0, 0);
        o[1][nt] = __builtin_amdgcn_mfma_f32_16x16x32_bf16(vf, pf[1], o[1][nt], 0, 0, 0);
      }
    }
    __syncthreads();
    if (done) break;
  }
#pragma unroll
  for (int mt = 0; mt < 2; mt++) {
    u16* op = p.mixcat() + (long)(q0 + w * 32 + mt * 16 + fr) * DM + 1024 + h * 128;
#pragma unroll
    for (int nt = 0; nt < 8; nt++) {
      f32x4 a = o[mt][nt];
      store_bf4(op + nt * 16 + fq * 4, a[0], a[1], a[2], a[3]);
    }
  }
}

__device__ void phase_mix(const Params& p, u16* smem) {
  const int NA = 8 * 64, NG = 64 * 8;
#ifndef NO_ATTN
  for (int j = blockIdx.x; j < NA; j += gridDim.x) { int qt = 63 - (j >> 3), h = j & 7; attn_item(p, h, qt, smem); }
#endif
#ifndef NO_GMLP
  for (int j = blockIdx.x; j < NG; j += gridDim.x) gmlp_item(p, j >> 3, j & 7, smem);
#endif
  for (int j = gridDim.x - 1 - blockIdx.x; j < 64; j += gridDim.x) memkv_tile(p, j, smem);
}

template <bool RES_BF16>
__device__ __forceinline__ void gemm_residual(const u16* A, const u16* WT, const void* res_, float* pre, u16* smem) {
  const int MT = SEQ / 128, NT = DM / 128;
  gemm_stream(MT * NT, DM, DM, DM, smem,
              [&](int j) { int mt = j % MT, nt = j / MT; TileDesc d; d.A = A; d.B = WT + (long)nt * 128 * DM; d.m0 = mt * 128; return d; },
              [&](int j, int m, int nb, f32x4 (&a)[4]) {
                int mt = j % MT, nt = j / MT;
                const long off = (long)(mt * 128 + m) * DM + nt * 128 + nb;
#pragma unroll
                for (int q = 0; q < 4; q++) {
                  float4 xv;
                  if (RES_BF16) {
                    uint2 xw = *(const uint2*)((const u16*)res_ + off + q * 16);
                    xv.x = bflo(xw.x); xv.y = bfhi(xw.x); xv.z = bflo(xw.y); xv.w = bfhi(xw.y);
                  } else {
                    xv = *(const float4*)((const float*)res_ + off + q * 16);
                  }
                  float4 r; r.x = DN_ALPHA * xv.x + a[q][0]; r.y = DN_ALPHA * xv.y + a[q][1]; r.z = DN_ALPHA * xv.z + a[q][2]; r.w = DN_ALPHA * xv.w + a[q][3];
                  *(float4*)(pre + off + q * 16) = r;
                }
              });
}
__device__ void phase_mixout(const Params& p, u16* smem) { gemm_residual<false>(p.mixcat(), p.WmixT(), p.x, p.pre(), smem); }
__device__ void phase_oproj(const Params& p, u16* smem) { gemm_residual<true>(p.om(), p.WoT(), p.hb(), p.pre(), smem); }

__device__ void phase_qproj(const Params& p, u16* smem) {
  const int MT = SEQ / 128, NT = DM / 128;
  const u16* hb = p.hb(); const u16* WqT = p.WqT(); u16* qm = p.qm();
  gemm_stream(MT * NT, DM, DM, DM, smem,
              [&](int j) { int mt = j % MT, nt = j / MT; TileDesc d; d.A = hb; d.B = WqT + (long)nt * 128 * DM; d.m0 = mt * 128; return d; },
              [&](int j, int m, int nb, f32x4 (&a)[4]) {
                int mt = j % MT, nt = j / MT;
                u16* outp = qm + (long)(mt * 128 + m) * DM + nt * 128 + nb;
                const float sc = 0.04419417382415922f;
#pragma unroll
                for (int q = 0; q < 4; q++) store_bf4(outp + q * 16, a[q][0] * sc, a[q][1] * sc, a[q][2] * sc, a[q][3] * sc);
              });
}

__device__ void phase_scores(const Params& p, u16* smem) {
  const int MT = SEQ / 128;
  const u16* qm = p.qm(); const u16* kmem = p.kmem(); float* scores = p.scores();
  gemm_stream(4 * MT * 2, DM, DM, 512, smem,
              [&](int j) { int mt = j % MT, r_ = j / MT, nt = r_ & 1, h = r_ >> 1; TileDesc d; d.A = qm + h * 512; d.B = kmem + (long)nt * 128 * DM + h * 512; d.m0 = mt * 128; return d; },
              [&](int j, int m, int nb, f32x4 (&a)[4]) {
                int mt = j % MT, r_ = j / MT, nt = r_ & 1, h = r_ >> 1;
                float* outp = scores + ((long)h * SEQ + mt * 128 + m) * MEML + nt * 128 + nb;
#pragma unroll
                for (int q = 0; q < 4; q++) {
                  float4 r4; r4.x = a[q][0]; r4.y = a[q][1]; r4.z = a[q][2]; r4.w = a[q][3];
                  *(float4*)(outp + q * 16) = r4;
                }
              });
}

__device__ void phase_softmax(const Params& p) {
  const int wpb = 4, lane = threadIdx.x & 63, wid = threadIdx.x >> 6;
  const int nrows = 4 * SEQ;
  for (int r = blockIdx.x * wpb + wid; r < nrows; r += gridDim.x * wpb) {
    float4 v = *(const float4*)(p.scores() + (long)r * MEML + lane * 4);
    float mx = wave_max(fmaxf(fmaxf(v.x, v.y), fmaxf(v.z, v.w)));
    float e0 = __expf(v.x - mx), e1 = __expf(v.y - mx), e2 = __expf(v.z - mx), e3 = __expf(v.w - mx);
    float inv = 1.f / wave_sum(e0 + e1 + e2 + e3);
    store_bf4(p.Pm() + (long)r * MEML + lane * 4, e0 * inv, e1 * inv, e2 * inv, e3 * inv);
  }
}

__device__ void phase_pv(const Params& p, u16* smem) {
  const int MT = SEQ / 128;
  const u16* Pm = p.Pm(); const u16* vmemT = p.vmemT(); u16* om = p.om();
  gemm_stream(4 * MT * 4, MEML, MEML, MEML, smem,
              [&](int j) { int mt = j % MT, r_ = j / MT, nt = r_ & 3, h = r_ >> 2; TileDesc d; d.A = Pm + (long)h * SEQ * MEML; d.B = vmemT + (long)(h * 512 + nt * 128) * MEML; d.m0 = mt * 128; return d; },
              [&](int j, int m, int nb, f32x4 (&a)[4]) {
                int mt = j % MT, r_ = j / MT, nt = r_ & 3, h = r_ >> 2;
                u16* outp = om + (long)(mt * 128 + m) * DM + h * 512 + nt * 128 + nb;
#pragma unroll
                for (int q = 0; q < 4; q++) store_bf4(outp + q * 16, a[q][0], a[q][1], a[q][2], a[q][3]);
              });
}

__device__ __forceinline__ void ln_stats(const float (&v)[32], float& mean, float& rstd) {
  float s = 0.f;
#pragma unroll
  for (int i = 0; i < 32; i++) s += v[i];
  mean = wave_sum(s) * (1.f / DM);
  float q = 0.f;
#pragma unroll
  for (int i = 0; i < 32; i++) { float d = v[i] - mean; q += d * d; }
  rstd = rsqrtf(wave_sum(q) * (1.f / DM) + 1e-5f);
}

typedef const f32x4 __attribute__((address_space(1)))* g_cv4;
typedef f32x4 __attribute__((address_space(1)))* g_v4;
typedef unsigned int u32x2 __attribute__((ext_vector_type(2)));
typedef const u32x2 __attribute__((address_space(1)))* g_cu2;
typedef u32x2 __attribute__((address_space(1)))* g_u2;
template <class G, class T> __device__ __forceinline__ G opaque_g(T* q) { asm volatile("" : "+v"(q)); return (G)q; }

template <int MODE>
__device__ void phase_ln(const Params& p, u16* smem) {
  const int lane = threadIdx.x & 63, wid = threadIdx.x >> 6;
  const float* gam = MODE == 0 ? p.ln1_g : p.ln3_g;
  const float* bet = MODE == 0 ? p.ln1_b : p.ln3_b;
  for (int rb = (blockIdx.x * 4 + wid) * 2; rb < SEQ; rb += gridDim.x * 8) {
    float v[2][32];
#pragma unroll
    for (int q = 0; q < 2; q++) {
      const int r = rb + q;
      if (MODE == 0) {
        g_cv4 pr = opaque_g<g_cv4>(p.pre() + (long)r * DM + lane * 4);
#pragma unroll
        for (int i = 0; i < 8; i++) {
          f32x4 a = pr[i * 64];
          v[q][i * 4 + 0] = a[0]; v[q][i * 4 + 1] = a[1]; v[q][i * 4 + 2] = a[2]; v[q][i * 4 + 3] = a[3];
        }
      } else {
        g_cu2 ph = opaque_g<g_cu2>(p.hb() + (long)r * DM + lane * 4);
        g_cu2 py0 = opaque_g<g_cu2>(p.yslot() + (long)(2 * r) * DM + lane * 4);
        g_cu2 py1 = opaque_g<g_cu2>(p.yslot() + (long)(2 * r + 1) * DM + lane * 4);
#pragma unroll
        for (int i = 0; i < 8; i++) {
          u32x2 hw = ph[i * 64], y0 = py0[i * 64], y1 = py1[i * 64];
          v[q][i * 4 + 0] = DN_ALPHA * bflo(hw[0]) + (bflo(y0[0]) + bflo(y1[0]));
          v[q][i * 4 + 1] = DN_ALPHA * bfhi(hw[0]) + (bfhi(y0[0]) + bfhi(y1[0]));
          v[q][i * 4 + 2] = DN_ALPHA * bflo(hw[1]) + (bflo(y0[1]) + bflo(y1[1]));
          v[q][i * 4 + 3] = DN_ALPHA * bfhi(hw[1]) + (bfhi(y0[1]) + bfhi(y1[1]));
        }
      }
    }
    float mean[2], rstd[2];
    ln_stats(v[0], mean[0], rstd[0]);
    ln_stats(v[1], mean[1], rstd[1]);
    g_cv4 pg = opaque_g<g_cv4>(gam + lane * 4);
    g_cv4 pb = opaque_g<g_cv4>(bet + lane * 4);
#pragma unroll
    for (int q = 0; q < 2; q++) {
      g_v4 po = opaque_g<g_v4>(p.out + (long)(rb + q) * DM + lane * 4);
      g_u2 ph = opaque_g<g_u2>(p.hb() + (long)(rb + q) * DM + lane * 4);
#pragma unroll
      for (int i = 0; i < 8; i++) {
        f32x4 g = pg[i * 64], b = pb[i * 64];
        f32x4 o4;
#pragma unroll
        for (int e = 0; e < 4; e++) o4[e] = (v[q][i * 4 + e] - mean[q]) * rstd[q] * g[e] + b[e];
        if (MODE == 2) po[i * 64] = o4;
        else { u32x2 w = {pack2(o4[0], o4[1]), pack2(o4[2], o4[3])}; ph[i * 64] = w; }
      }
    }
  }
}

typedef const f32x4 __attribute__((address_space(1)))* gv4p;
__device__ __forceinline__ gv4p launder_g(const float* q) { asm volatile("" : "+v"(q)); return (gv4p)q; }

__device__ __forceinline__ void wave_reduce8(float (&a)[8], int lane) {
  float b[4], c[2], d;
  const bool h5 = lane & 32, h4 = lane & 16, h3 = lane & 8;
#pragma unroll
  for (int k = 0; k < 4; k++) {
    float send = h5 ? a[k] : a[k + 4];
    float keep = h5 ? a[k + 4] : a[k];
    b[k] = keep + __shfl_xor(send, 32);
  }
#pragma unroll
  for (int k = 0; k < 2; k++) {
    float send = h4 ? b[k] : b[k + 2];
    float keep = h4 ? b[k + 2] : b[k];
    c[k] = keep + __shfl_xor(send, 16);
  }
  {
    float send = h3 ? c[0] : c[1];
    float keep = h3 ? c[1] : c[0];
    d = keep + __shfl_xor(send, 8);
  }
  d += __shfl_xor(d, 4);
  d += __shfl_xor(d, 2);
  d += __shfl_xor(d, 1);
#pragma unroll
  for (int g = 0; g < 8; g++) a[g] = __shfl(d, ((g >> 2) & 1) * 32 + ((g >> 1) & 1) * 16 + (g & 1) * 8);
}

__device__ void phase_ln2_route(const Params& p) {
  const int lane = threadIdx.x & 63, wid = threadIdx.x >> 6;
  const float* wgT = p.wgT();
  const float* wrT = p.wrT();
#define CH(i) ((i) * 256)
  for (int rb = (blockIdx.x * 4 + wid) * 2; rb < SEQ; rb += gridDim.x * 8) {
    float v[2][32];
#pragma unroll
    for (int q = 0; q < 2; q++)
#pragma unroll
      for (int i = 0; i < 8; i++) {
        f32x4 a = *(const f32x4*)(p.pre() + (long)(rb + q) * DM + CH(i) + lane * 4);
        v[q][i * 4 + 0] = a[0]; v[q][i * 4 + 1] = a[1]; v[q][i * 4 + 2] = a[2]; v[q][i * 4 + 3] = a[3];
      }
    float mean[2], rstd[2];
    ln_stats(v[0], mean[0], rstd[0]);
    ln_stats(v[1], mean[1], rstd[1]);
#pragma unroll
    for (int i = 0; i < 8; i++) {
      int c = CH(i) + lane * 4;
      f32x4 g = *(const f32x4*)(p.ln2_g + c), b = *(const f32x4*)(p.ln2_b + c);
#pragma unroll
      for (int q = 0; q < 2; q++) {
        f32x4 o4;
#pragma unroll
        for (int e = 0; e < 4; e++) { o4[e] = (v[q][i * 4 + e] - mean[q]) * rstd[q] * g[e] + b[e]; v[q][i * 4 + e] = o4[e]; }
        store_bf4(p.hb() + (long)(rb + q) * DM + c, o4[0], o4[1], o4[2], o4[3]);
      }
    }
    float lg[2][8];
    {
      f32x4 wb[2][8];
      {
        gv4p wp = launder_g(wgT + lane * 4);
#pragma unroll
        for (int i = 0; i < 8; i++) wb[0][i] = wp[CH(i) >> 2];
      }
#pragma unroll
      for (int g = 0; g < 8; g++) {
        if (g + 1 < 8) {
          gv4p wp = launder_g(wgT + (g + 1) * DM + lane * 4);
#pragma unroll
          for (int i = 0; i < 8; i++) wb[(g + 1) & 1][i] = wp[CH(i) >> 2];
        }
        __builtin_amdgcn_sched_barrier(0);
        float s0 = 0.f, s1 = 0.f;
#pragma unroll
        for (int i = 0; i < 8; i++)
#pragma unroll
          for (int e = 0; e < 4; e++) { s0 += wb[g & 1][i][e] * v[0][i * 4 + e]; s1 += wb[g & 1][i][e] * v[1][i * 4 + e]; }
        lg[0][g] = s0; lg[1][g] = s1;
        __builtin_amdgcn_sched_barrier(0);
      }
    }
    wave_reduce8(lg[0], lane);
    wave_reduce8(lg[1], lane);
    int gi[2]; float gval[2];
#pragma unroll
    for (int q = 0; q < 2; q++) {
#pragma unroll
      for (int g = 0; g < 8; g++) lg[q][g] += p.b_group[g];
      int bi = 0; float gm = lg[q][0];
#pragma unroll
      for (int g = 1; g < 8; g++) if (lg[q][g] > gm) { gm = lg[q][g]; bi = g; }
      float gs = 0.f;
#pragma unroll
      for (int g = 0; g < 8; g++) gs += __expf(lg[q][g] - gm);
      gval[q] = 1.f / gs;
      gi[q] = __builtin_amdgcn_readfirstlane(bi);
    }
    float le[2][8];
    {
      const float* wr0_ = wrT + (long)gi[0] * 8 * DM;
      const float* wr1_ = wrT + (long)gi[1] * 8 * DM;
      f32x4 wb[2][8];
      {
        gv4p wp = launder_g(wr0_ + lane * 4);
#pragma unroll
        for (int i = 0; i < 8; i++) wb[0][i] = wp[CH(i) >> 2];
      }
#pragma unroll
      for (int u = 0; u < 16; u++) {
        if (u + 1 < 16) {
          gv4p wp = launder_g((((u + 1) >> 3) ? wr1_ : wr0_) + ((u + 1) & 7) * DM + lane * 4);
#pragma unroll
          for (int i = 0; i < 8; i++) wb[(u + 1) & 1][i] = wp[CH(i) >> 2];
        }
        __builtin_amdgcn_sched_barrier(0);
        float s0 = 0.f;
#pragma unroll
        for (int i = 0; i < 8; i++)
#pragma unroll
          for (int e = 0; e < 4; e++) s0 += wb[u & 1][i][e] * v[u >> 3][i * 4 + e];
        le[u >> 3][u & 7] = s0;
        __builtin_amdgcn_sched_barrier(0);
      }
    }
    wave_reduce8(le[0], lane);
    wave_reduce8(le[1], lane);
#pragma unroll
    for (int q = 0; q < 2; q++) {
#pragma unroll
      for (int g = 0; g < 8; g++) le[q][g] += p.b_router[gi[q] * 8 + g];
      int i1 = 0; float v1 = le[q][0];
#pragma unroll
      for (int g = 1; g < 8; g++) if (le[q][g] > v1) { v1 = le[q][g]; i1 = g; }
      int i2 = 0; float v2 = -3.0e38f;
#pragma unroll
      for (int g = 0; g < 8; g++) if (g != i1 && le[q][g] > v2) { v2 = le[q][g]; i2 = g; }
      float e2 = __expf(v2 - v1);
      float g1 = gval[q] / (1.f + e2), g2 = gval[q] * e2 / (1.f + e2);
      if (lane == 0) {
        const int r = rb + q;
        int ea = gi[q] * 8 + i1, eb = gi[q] * 8 + i2;
        int pa = atomicAdd(&p.cnt()[ea * 32], 1);
        p.rowlist()[ea * SEQ + pa] = 2 * r;
        p.gates()[2 * r] = g1;
        int pb = atomicAdd(&p.cnt()[eb * 32], 1);
        p.rowlist()[eb * SEQ + pb] = 2 * r + 1;
        p.gates()[2 * r + 1] = g2;
      }
    }
  }
}
#undef CH

template <int STAGE>
__device__ void phase_moe(const Params& p, u16* smem) {
  int* sInfo = (int*)(smem + 32768);
  int* sPref = sInfo;
  int* sArow = sInfo + 128;
  int* sAsg = sInfo + 256;
  const int t = threadIdx.x;
  const int xg = (gridDim.x >= 8) ? (int)(blockIdx.x & 7) : 0;
  const int ngrp = (gridDim.x >= 8) ? 8 : 1;
  const int lb = (gridDim.x >= 8) ? (int)(blockIdx.x >> 3) : (int)blockIdx.x;
  const int nlb = (gridDim.x >= 8) ? (int)((gridDim.x - xg + 7) >> 3) : (int)gridDim.x;
  const int nex = NEXP / ngrp;
  if (t == 0) {
    int acc = 0;
    for (int q = 0; q < nex; q++) { sPref[q] = acc; acc += (p.cnt()[(xg + ngrp * q) * 32] + 127) >> 7; }
    sPref[nex] = acc;
  }
  __syncthreads();
  const int NT = STAGE == 0 ? (DEXP / 64) : (DM / 128);
  const int total = sPref[nex] * NT;
  for (int j = lb; j < total; j += nlb) {
    int nt = j % NT, mg = j / NT;
    int eq = 0;
    for (int q = 0; q < nex; q++) if (sPref[q + 1] <= mg) eq = q + 1;
    int mt = mg - sPref[eq];
    const int e = xg + ngrp * eq;
    int ce = p.cnt()[e * 32];
    if (t < 128) {
      int idx = mt * 128 + t;
      int a = idx < ce ? p.rowlist()[e * SEQ + idx] : -1;
      sAsg[t] = a;
      sArow[t] = a < 0 ? 0 : (STAGE == 0 ? (a >> 1) : a);
    }
    __syncthreads();
    if (STAGE == 0) {
      const float* W1 = p.w1 + (long)e * DM * DEXP + nt * 64;
      const float* W3 = p.w3 + (long)e * DM * DEXP + nt * 64;
      u16* hidp = p.hid() + nt * 64;
      gemm_tile_wf32(p.hb(), DM, sArow,
                [&](int& k, int& v, const float*& src) {
                  int which = (t >> 4) & 1;
                  k = t >> 5;
                  int c4 = (t & 15) * 4;
                  v = (c4 >> 4) * 32 + which * 16 + (c4 & 15);
                  src = (which ? W3 : W1) + (long)k * DEXP + c4;
                }, DEXP, DM, smem,
                [&](int m, int nb, f32x4 (&a)[4]) {
                  int as = sAsg[m];
                  if (as >= 0) {
                    int wc = nb >> 6, f4 = nb & 63;
#pragma unroll
                    for (int q = 0; q < 2; q++) {
                      f32x4 g = a[2 * q], u = a[2 * q + 1];
                      float r0 = g[0] / (1.f + __expf(-g[0])) * u[0];
                      float r1 = g[1] / (1.f + __expf(-g[1])) * u[1];
                      float r2 = g[2] / (1.f + __expf(-g[2])) * u[2];
                      float r3 = g[3] / (1.f + __expf(-g[3])) * u[3];
                      store_bf4(hidp + (long)as * DEXP + (wc * 2 + q) * 16 + f4, r0, r1, r2, r3);
                    }
                  }
                });
    } else {
      const float* W2 = p.w2 + (long)e * DEXP * DM + nt * 128;
      u16* yp = p.yslot() + nt * 128;
      const float* gp = p.gates();
      gemm_tile_wf32(p.hid(), DEXP, sArow,
                [&](int& k, int& v, const float*& src) {
                  k = t >> 5;
                  v = (t & 31) * 4;
                  src = W2 + (long)k * DM + v;
                }, DM, DEXP, smem,
                [&](int m, int nb, f32x4 (&a)[4]) {
                  int as = sAsg[m];
                  if (as >= 0) {
                    float gt = gp[as];
#pragma unroll
                    for (int q = 0; q < 4; q++) store_bf4(yp + (long)as * DM + nb + q * 16, gt * a[q][0], gt * a[q][1], gt * a[q][2], gt * a[q][3]);
                  }
                });
    }
    __syncthreads();
  }
}


#define XB_TMO      128
#define XB_XCNT(j)  (256  + 64 * (j))
#define XB_XSUB(j)  (1280 + 64 * (j))
#define XB_XGEN(j)  (2304 + 64 * (j))
#define XB_TOP      3328
#define XB_TOPGEN   3392
#define XCD_BAR_WORDS 3456
#define XB_SPIN_CAP (1u << 22)
__device__ __forceinline__ unsigned xb_ld(unsigned* p) { return __hip_atomic_load(p, __ATOMIC_RELAXED, __HIP_MEMORY_SCOPE_AGENT); }
__device__ __forceinline__ unsigned xb_add(unsigned* p, unsigned v) { return __hip_atomic_fetch_add(p, v, __ATOMIC_RELAXED, __HIP_MEMORY_SCOPE_AGENT); }
__device__ __forceinline__ unsigned xb_xcc_id() { return (unsigned)__builtin_amdgcn_s_getreg((3 << 11) | 20) & 0xFu; }
#define XB_SPIN(cond, bar) do { unsigned _sp = 0; while (cond) { __builtin_amdgcn_s_sleep(1); \
    if ((++_sp & 255u) == 0u) { if (xb_ld(&(bar)[XB_TMO])) break; if (_sp > XB_SPIN_CAP) { atomicAdd(&(bar)[XB_TMO], 1u); break; } } } } while (0)
struct XcdBarrier { unsigned* bar; unsigned x; volatile LAS unsigned* st; };
__device__ __forceinline__ XcdBarrier xcd_barrier_post(unsigned* bar, volatile LAS unsigned* st) {
  XcdBarrier b; b.bar = bar; b.x = xb_xcc_id(); b.st = st;
  if (threadIdx.x == 0) (void)xb_add(&bar[XB_XCNT(b.x)], 1u);
  return b;
}
__device__ __forceinline__ void xcd_barrier_complete(unsigned* bar, unsigned x, unsigned& nloc, unsigned& nx) {
  const unsigned G = gridDim.x;
  unsigned sum, cnt, mine, sp = 0u;
  for (;;) {
    sum = 0u; cnt = 0u; mine = 0u;
#pragma unroll
    for (unsigned j = 0; j < 16; ++j) { const unsigned c = xb_ld(&bar[XB_XCNT(j)]); sum += c; cnt += (c > 0u) ? 1u : 0u; mine = (j == x) ? c : mine; }
    if (sum == G) break;
    __builtin_amdgcn_s_sleep(1);
    if ((++sp & 255u) == 0u) { if (xb_ld(&bar[XB_TMO])) break; if (sp > XB_SPIN_CAP) { atomicAdd(&bar[XB_TMO], 1u); break; } }
  }
  nloc = mine > 0u ? mine : 1u; nx = cnt > 0u ? cnt : 1u;
}
__device__ __forceinline__ void xcd_barrier(const XcdBarrier& b) {
  asm volatile("s_waitcnt vmcnt(0)" ::: "memory");
  __syncthreads();
  if (threadIdx.x == 0) {
    unsigned* bar = b.bar;
    __builtin_amdgcn_s_waitcnt(0);
    unsigned nloc = b.st[0], nx = b.st[1];
    if (nloc == 0u) { xcd_barrier_complete(bar, b.x, nloc, nx); b.st[0] = nloc; b.st[1] = nx; }
    const unsigned old = xb_add(&bar[XB_XSUB(b.x)], 1u);
    const unsigned gen = old / nloc;
    if (old + 1u == (gen + 1u) * nloc) {
      __builtin_amdgcn_fence(__ATOMIC_RELEASE, "agent");
      asm volatile("s_waitcnt vmcnt(0)" ::: "memory");
      const unsigned og = xb_add(&bar[XB_TOP], 1u);
      const unsigned tg = og / nx;
      if (og + 1u == (tg + 1u) * nx) xb_add(&bar[XB_TOPGEN], 1u);
      else XB_SPIN(xb_ld(&bar[XB_TOPGEN]) == tg, bar);
      __builtin_amdgcn_fence(__ATOMIC_ACQUIRE, "agent");
      xb_add(&bar[XB_XGEN(b.x)], 1u);
      asm volatile("s_waitcnt vmcnt(0)" ::: "memory");
    } else {
      XB_SPIN(xb_ld(&bar[XB_XGEN(b.x)]) == gen, bar);
      __builtin_amdgcn_fence(__ATOMIC_ACQUIRE, "agent");
      asm volatile("s_waitcnt vmcnt(0)" ::: "memory");
    }
  }
  __syncthreads();
}

constexpr int NPH = 14;
__device__ __forceinline__ void run_phase(const Params& p, int ph, u16* smem) {
  switch (ph) {
    case 0: phase_convert(p, smem); break;
    case 1: phase_inproj(p, smem); break;
    case 2: phase_mix(p, smem); break;
    case 3: phase_mixout(p, smem); break;
    case 4: phase_ln<0>(p, smem); break;
    case 5: phase_qproj(p, smem); break;
    case 6: phase_scores(p, smem); break;
    case 7: phase_softmax(p); break;
    case 8: phase_pv(p, smem); break;
    case 9: phase_oproj(p, smem); break;
    case 10: phase_ln2_route(p); break;
    case 11: phase_moe<0>(p, smem); break;
    case 12: phase_moe<1>(p, smem); break;
    case 13: phase_ln<2>(p, smem); break;
  }
}

__global__ void __launch_bounds__(256, 2) mega_kernel(Params p) {
  extern __shared__ __attribute__((aligned(16))) u16 smem[];
  __shared__ uint4 xb_words;
  cg::grid_group grid = cg::this_grid();
  if (threadIdx.x == 0) xb_words = make_uint4(0u, 0u, 0u, 0u);
  __syncthreads();
  const XcdBarrier xb = xcd_barrier_post(p.bar(), (volatile LAS unsigned*)&xb_words);
  if (p.ws == nullptr) grid.sync();
#define GSYNC() xcd_barrier(xb)
#ifdef ONLY_PH
  run_phase(p, ONLY_PH, smem); GSYNC();
  return;
#endif
  run_phase(p, 0, smem); GSYNC();
  run_phase(p, 1, smem); GSYNC();
  run_phase(p, 2, smem); GSYNC();
  run_phase(p, 3, smem); GSYNC();
  run_phase(p, 4, smem); GSYNC();
  run_phase(p, 5, smem); GSYNC();
  run_phase(p, 6, smem); GSYNC();
  run_phase(p, 7, smem); GSYNC();
  run_phase(p, 8, smem); GSYNC();
  run_phase(p, 9, smem); GSYNC();
  run_phase(p, 10, smem); GSYNC();
  run_phase(p, 11, smem); GSYNC();
  run_phase(p, 12, smem); GSYNC();
  run_phase(p, 13, smem);
}

extern "C" void kernel_launch(void* const* d_in, const int* in_sizes, int n_in, void* d_out, int out_size, void* d_ws,
                              size_t ws_size, hipStream_t stream) {
  static int grid_blocks = 0;
  if (!grid_blocks) {
    int dev = 0, cus = 0, per_cu = 0;
    hipGetDevice(&dev);
    hipDeviceGetAttribute(&cus, hipDeviceAttributeMultiprocessorCount, dev);
    hipFuncSetAttribute((const void*)mega_kernel, hipFuncAttributeMaxDynamicSharedMemorySize, LDS_BYTES);
    hipOccupancyMaxActiveBlocksPerMultiprocessor(&per_cu, (const void*)mega_kernel, 256, LDS_BYTES);
    if (per_cu < 1) per_cu = 1;
    if (per_cu > 2) per_cu = 2;
    grid_blocks = cus * per_cu;
  }
  Params p{};
  const float* const* in = (const float* const*)d_in;
  p.x = in[0]; p.mem = in[1]; p.w_in = in[2]; p.gm_ln_g = in[3]; p.gm_ln_b = in[4]; p.gm_w_s = in[5]; p.gm_b_s = in[6];
  p.w_mix_out = in[7]; p.ln1_g = in[8]; p.ln1_b = in[9]; p.mem_w_q = in[10]; p.mem_w_k = in[11]; p.mem_w_v = in[12];
  p.mem_w_o = in[13]; p.ln2_g = in[14]; p.ln2_b = in[15]; p.w_group = in[16]; p.b_group = in[17]; p.w_router = in[18];
  p.b_router = in[19]; p.w1 = in[20]; p.w3 = in[21]; p.w2 = in[22]; p.ln3_g = in[23]; p.ln3_b = in[24];
  p.out = (float*)d_out;
  p.ws = (char*)d_ws;
  if (ws_size < 756 * MB) { fprintf(stderr, "workspace too small: %zu\n", ws_size); return; }
  hipMemsetAsync((char*)d_ws + 754 * MB, 0, XCD_BAR_WORDS * sizeof(unsigned), stream);
  void* args[] = {&p};
  hipError_t e = hipLaunchCooperativeKernel((const void*)mega_kernel, dim3(grid_blocks), dim3(256), args, LDS_BYTES, stream);
  if (e != hipSuccess) fprintf(stderr, "cooperative launch failed: %s (grid %d)\n", hipGetErrorString(e), grid_blocks);
}
```

```cpp
#include <hip/hip_runtime.h>
#include <hip/hip_cooperative_groups.h>
#include <stdint.h>
#include <stdio.h>
namespace cg = cooperative_groups;

typedef unsigned short u16;
using bf16x8 = __attribute__((ext_vector_type(8))) short;
using f32x4 = __attribute__((ext_vector_type(4))) float;
using u32x4 = __attribute__((ext_vector_type(4))) unsigned int;
#define LAS __attribute__((address_space(3)))

constexpr int SEQ = 8192, DM = 2048, INW = 5120, MEML = 256;
constexpr int NEXP = 64, DEXP = 512;
constexpr float DN_ALPHA = 1.189207115002721f;
constexpr float SB_THRESH = 40.f;
constexpr int LDS_BYTES = 73728;
constexpr size_t MB = 1u << 20;

struct Params {
  const float *x, *mem, *w_in, *gm_ln_g, *gm_ln_b, *gm_w_s, *gm_b_s, *w_mix_out, *ln1_g, *ln1_b;
  const float *mem_w_q, *mem_w_k, *mem_w_v, *mem_w_o, *ln2_g, *ln2_b, *w_group, *b_group, *w_router, *b_router;
  const float *w1, *w3, *w2, *ln3_g, *ln3_b;
  float* out;
  char* ws;
#define WSP(T, name, offmb) __device__ __forceinline__ T* name() const { return (T*)(ws + (size_t)(offmb) * MB); }
  WSP(u16, WinT, 0) WSP(u16, WmixT, 20) WSP(u16, WqT, 28) WSP(u16, WkT, 36) WSP(u16, WvT, 44) WSP(u16, WoT, 52)
  WSP(u16, W1T, 60) WSP(u16, W3T, 188) WSP(u16, W2T, 316)
  WSP(u16, xb, 444)
  WSP(float, scores, 444)
  WSP(u16, memb, 476) WSP(u16, kmem, 477) WSP(u16, vmemT, 478)
  WSP(u16, proj, 479)
  WSP(u16, qm, 479)
  WSP(u16, om, 511)
  WSP(u16, yslot, 479)
  WSP(u16, mixcat, 559)
  WSP(u16, Pm, 559)
  WSP(u16, hid, 575)
  WSP(float, pre, 591)
  WSP(float, hf, 655)
  WSP(u16, hb, 719)
  WSP(int, cnt, 751)
  __device__ __forceinline__ float* gates() const { return (float*)(ws + 751 * MB + 65536); }
  WSP(int, rowlist, 752)
  WSP(unsigned, bar, 754)
  WSP(float, wgT, 755)
  __device__ __forceinline__ float* wrT() const { return (float*)(ws + 755 * MB + 65536); }
};

__device__ __forceinline__ uint32_t pack2(float a, float b);
__device__ __forceinline__ u16 f2bf(float f) { return (u16)(pack2(f, f) & 0xffffu); }
__device__ __forceinline__ float bflo(uint32_t w) { return __uint_as_float(w << 16); }
__device__ __forceinline__ float bfhi(uint32_t w) { return __uint_as_float(w & 0xffff0000u); }
typedef float f32x2_t __attribute__((ext_vector_type(2)));
typedef __bf16 bf16x2_t __attribute__((ext_vector_type(2)));
__device__ __forceinline__ uint32_t pack2(float a, float b) {
  f32x2_t v = {a, b};
  bf16x2_t r = __builtin_convertvector(v, bf16x2_t);
  return __builtin_bit_cast(uint32_t, r);
}
__device__ __forceinline__ float gelu_tanh(float x) {
  float u = 0.7978845608028654f * (x + 0.044715f * x * x * x);
  float e = __expf(2.f * u);
  float th = 1.f - 2.f / (e + 1.f);
  return 0.5f * x * (1.f + th);
}
__device__ __forceinline__ float wave_sum(float v) {
#pragma unroll
  for (int o = 32; o; o >>= 1) v += __shfl_xor(v, o);
  return v;
}
__device__ __forceinline__ float wave_max(float v) {
#pragma unroll
  for (int o = 32; o; o >>= 1) v = fmaxf(v, __shfl_xor(v, o));
  return v;
}
__device__ __forceinline__ void store_bf4(u16* dst, float a, float b, float c, float d) {
  uint2 w; w.x = pack2(a, b); w.y = pack2(c, d);
  *(uint2*)dst = w;
}

__device__ __forceinline__ void mma_128x128x64(const u16* sA, const u16* sB, f32x4 (&acc)[4][4], int wr, int wc, int fr, int fq) {
#pragma unroll
  for (int ks = 0; ks < 2; ks++) {
    bf16x8 af[4], bfr[4];
#pragma unroll
    for (int mt = 0; mt < 4; mt++) {
      int row = wr * 64 + mt * 16 + fr;
      int ch = (ks * 4 + fq) ^ ((row >> 1) & 7);
      af[mt] = *(const bf16x8*)(sA + row * 64 + ch * 8);
    }
#pragma unroll
    for (int nt = 0; nt < 4; nt++) {
      int row = wc * 64 + nt * 16 + fr;
      int ch = (ks * 4 + fq) ^ ((row >> 1) & 7);
      bfr[nt] = *(const bf16x8*)(sB + row * 64 + ch * 8);
    }
    __builtin_amdgcn_s_setprio(1);
#pragma unroll
    for (int mt = 0; mt < 4; mt++)
#pragma unroll
      for (int nt = 0; nt < 4; nt++)
        acc[mt][nt] = __builtin_amdgcn_mfma_f32_16x16x32_bf16(bfr[nt], af[mt], acc[mt][nt], 0, 0, 0);
    __builtin_amdgcn_s_setprio(0);
  }
}

template <class BP, class Epi>
__device__ __forceinline__ void gemm_tile(const u16* __restrict__ A, long lda, const int* arow, int m0, BP bptr, int K,
                                          u16* smem, Epi epi) {
  const int t = threadIdx.x, lane = t & 63, wid = t >> 6, wr = wid >> 1, wc = wid & 1, fr = lane & 15, fq = lane >> 4;
  const int lr = t >> 3;
  const int gch = ((t & 7) ^ ((t >> 4) & 7)) << 3;
  const u16 *ap0, *ap1, *ap2, *ap3;
  {
    long g0 = arow ? (long)arow[lr] : (long)(m0 + lr);
    long g1 = arow ? (long)arow[lr + 32] : (long)(m0 + lr + 32);
    long g2 = arow ? (long)arow[lr + 64] : (long)(m0 + lr + 64);
    long g3 = arow ? (long)arow[lr + 96] : (long)(m0 + lr + 96);
    ap0 = A + g0 * lda + gch; ap1 = A + g1 * lda + gch; ap2 = A + g2 * lda + gch; ap3 = A + g3 * lda + gch;
  }
  const u16* bp0 = bptr(lr) + gch;
  const u16* bp1 = bptr(lr + 32) + gch;
  const u16* bp2 = bptr(lr + 64) + gch;
  const u16* bp3 = bptr(lr + 96) + gch;
  f32x4 acc[4][4];
#pragma unroll
  for (int i = 0; i < 4; i++)
#pragma unroll
    for (int j = 0; j < 4; j++) acc[i][j] = f32x4{0.f, 0.f, 0.f, 0.f};
#define GLDS(src, dst) __builtin_amdgcn_global_load_lds((const unsigned*)(src), (unsigned*)(dst), 16, 0, 0)
#define STAGE(k0, buf)                                                          \
  {                                                                             \
    u16* dA = smem + (buf) * 16384 + wid * 512;                                 \
    u16* dB = dA + 8192;                                                        \
    GLDS(ap0 + (k0), dA); GLDS(bp0 + (k0), dB);                                 \
    GLDS(ap1 + (k0), dA + 2048); GLDS(bp1 + (k0), dB + 2048);                   \
    GLDS(ap2 + (k0), dA + 4096); GLDS(bp2 + (k0), dB + 4096);                   \
    GLDS(ap3 + (k0), dA + 6144); GLDS(bp3 + (k0), dB + 6144);                   \
  }
  STAGE(0, 0);
  const int nk = K >> 6;
  for (int kt = 0; kt < nk; kt++) {
    asm volatile("s_waitcnt vmcnt(0)" ::: "memory");
    __syncthreads();
    if (kt + 1 < nk) STAGE((kt + 1) << 6, (kt + 1) & 1);
    const u16* sA = smem + (kt & 1) * 16384;
    mma_128x128x64(sA, sA + 8192, acc, wr, wc, fr, fq);
  }
#undef STAGE
#undef GLDS
#pragma unroll
  for (int mt = 0; mt < 4; mt++) epi(wr * 64 + mt * 16 + fr, wc * 64 + fq * 4, acc[mt]);
}

struct TileDesc { const u16* A; const u16* B; int m0; };
template <class Desc, class Epi>
__device__ __forceinline__ void gemm_stream(int total, long lda, long ldb, int K, u16* smem, Desc desc, Epi epi) {
  const int t = threadIdx.x, lane = t & 63, wid = t >> 6, wr = wid >> 1, wc = wid & 1, fr = lane & 15, fq = lane >> 4;
  const int lr = t >> 3;
  const int gch = ((t & 7) ^ ((t >> 4) & 7)) << 3;
  int j = blockIdx.x;
  if (j >= total) return;
  const u16 *ap, *bp;
  const long as32 = 32 * lda, bs32 = 32 * ldb;
#define SETUP(jj)                                                               \
  {                                                                             \
    TileDesc d_ = desc(jj);                                                     \
    ap = d_.A + (long)(d_.m0 + lr) * lda + gch;                                 \
    bp = d_.B + (long)lr * ldb + gch;                                           \
  }
#define GLDS(src, dst) __builtin_amdgcn_global_load_lds((const unsigned*)(src), (unsigned*)(dst), 16, 0, 0)
#define STAGE(k0, buf)                                                          \
  {                                                                             \
    u16* dA = smem + (buf) * 16384 + wid * 512;                                 \
    u16* dB = dA + 8192;                                                        \
    GLDS(ap + (k0), dA); GLDS(bp + (k0), dB);                                   \
    GLDS(ap + as32 + (k0), dA + 2048); GLDS(bp + bs32 + (k0), dB + 2048);       \
    GLDS(ap + 2 * as32 + (k0), dA + 4096); GLDS(bp + 2 * bs32 + (k0), dB + 4096); \
    GLDS(ap + 3 * as32 + (k0), dA + 6144); GLDS(bp + 3 * bs32 + (k0), dB + 6144); \
  }
  SETUP(j);
  STAGE(0, 0);
  const int nk = K >> 6;
  for (;;) {
    f32x4 acc[4][4];
#pragma unroll
    for (int i = 0; i < 4; i++)
#pragma unroll
      for (int q = 0; q < 4; q++) acc[i][q] = f32x4{0.f, 0.f, 0.f, 0.f};
    for (int kt = 0; kt < nk; kt++) {
      asm volatile("s_waitcnt vmcnt(0)" ::: "memory");
      __syncthreads();
      if (kt + 1 < nk) STAGE((kt + 1) << 6, (kt + 1) & 1);
      const u16* sA = smem + (kt & 1) * 16384;
      mma_128x128x64(sA, sA + 8192, acc, wr, wc, fr, fq);
    }
    const int jn = j + gridDim.x;
    const bool has = jn < total;
    if (has) { SETUP(jn); STAGE(0, 0); }
#pragma unroll
    for (int mt = 0; mt < 4; mt++) epi(j, wr * 64 + mt * 16 + fr, wc * 64 + fq * 4, acc[mt]);
    if (!has) break;
    j = jn;
  }
#undef SETUP
#undef STAGE
#undef GLDS
}

typedef short s16x4 __attribute__((ext_vector_type(4)));
__device__ __forceinline__ int wt_off(int k, int ch) { return 256 * k + 16 * (ch ^ (((k & 3) << 2) | ((k >> 2) & 3))); }

template <class WM, class Epi>
__device__ __forceinline__ void gemm_tile_wf32(const u16* __restrict__ A, long lda, const int* arow, WM wmap, long kstride, int K,
                                               u16* smem, Epi epi) {
  const int t = threadIdx.x, lane = t & 63, wid = t >> 6, wr = wid >> 1, wc = wid & 1, fr = lane & 15, fq = lane >> 4;
  const int lr = t >> 3;
  const int gch = ((t & 7) ^ ((t >> 4) & 7)) << 3;
  const unsigned ao0 = (unsigned)(arow[lr] * (int)lda + gch), ao1 = (unsigned)(arow[lr + 32] * (int)lda + gch);
  const unsigned ao2 = (unsigned)(arow[lr + 64] * (int)lda + gch), ao3 = (unsigned)(arow[lr + 96] * (int)lda + gch);
  const float* wp0;
  int woff0, woff1;
  {
    int kw, vw;
    wmap(kw, vw, wp0);
    woff0 = wt_off(kw, vw >> 3) + ((vw >> 2) & 1) * 8;
    woff1 = wt_off(kw + 8, vw >> 3) + ((vw >> 2) & 1) * 8;
  }
  f32x4 acc[4][4];
#pragma unroll
  for (int i = 0; i < 4; i++)
#pragma unroll
    for (int j = 0; j < 4; j++) acc[i][j] = f32x4{0.f, 0.f, 0.f, 0.f};
  f32x4 wr0[8], wr1[8];
#define GLDS(src, dst) __builtin_amdgcn_global_load_lds((const unsigned*)(src), (unsigned*)(dst), 16, 0, 0)
#define STAGE_A(k0, buf)                                                        \
  {                                                                             \
    u16* dA = smem + (buf) * 16384 + wid * 512;                                 \
    const u16* Ak = A + (k0);                                                   \
    GLDS(Ak + ao0, dA); GLDS(Ak + ao1, dA + 2048);                              \
    GLDS(Ak + ao2, dA + 4096); GLDS(Ak + ao3, dA + 6144);                       \
  }
#define LOAD_W(R, k0)                                                           \
  {                                                                             \
    _Pragma("unroll") for (int i = 0; i < 8; i++) R[i] = *(const f32x4*)(wp0 + (long)((k0) + 8 * i) * kstride); \
  }
#define WRITE_W(R, buf)                                                         \
  {                                                                             \
    char* dB = (char*)(smem + (buf) * 16384 + 8192);                            \
    _Pragma("unroll") for (int i = 0; i < 8; i++) {                             \
      uint2 w2; w2.x = pack2(R[i][0], R[i][1]); w2.y = pack2(R[i][2], R[i][3]); \
      *(uint2*)(dB + ((i & 1) ? woff1 : woff0) + 2048 * (i & ~1)) = w2;                                             \
    }                                                                           \
  }
#define COMPUTE(buf)                                                            \
  {                                                                             \
    const u16* sA = smem + (buf) * 16384;                                       \
    const char* sB = (const char*)(sA + 8192);                                  \
    _Pragma("unroll") for (int ks = 0; ks < 2; ks++) {                          \
      bf16x8 af[4], bfr[4];                                                     \
      _Pragma("unroll") for (int mt = 0; mt < 4; mt++) {                        \
        int row = wr * 64 + mt * 16 + fr;                                       \
        int ch = (ks * 4 + fq) ^ ((row >> 1) & 7);                              \
        af[mt] = *(const bf16x8*)(sA + row * 64 + ch * 8);                      \
      }                                                                         \
      _Pragma("unroll") for (int nt = 0; nt < 4; nt++) {                        \
        const int c0 = (wc * 64 + nt * 16) >> 3;                                \
        const int k0_ = ks * 32 + fq * 8 + tq;                                  \
        s16x4 lo = __builtin_amdgcn_ds_read_tr16_b64_v4i16((s16x4 LAS*)(sB + wt_off(k0_, c0 + (tp >> 1)) + 8 * (tp & 1)));     \
        s16x4 hi = __builtin_amdgcn_ds_read_tr16_b64_v4i16((s16x4 LAS*)(sB + wt_off(k0_ + 4, c0 + (tp >> 1)) + 8 * (tp & 1))); \
        bfr[nt] = bf16x8{lo[0], lo[1], lo[2], lo[3], hi[0], hi[1], hi[2], hi[3]}; \
      }                                                                         \
      _Pragma("unroll") for (int mt = 0; mt < 4; mt++)                          \
        _Pragma("unroll") for (int nt = 0; nt < 4; nt++)                        \
          acc[mt][nt] = __builtin_amdgcn_mfma_f32_16x16x32_bf16(bfr[nt], af[mt], acc[mt][nt], 0, 0, 0); \
    }                                                                           \
  }
  const int tq = fr >> 2, tp = fr & 3;
  const int trb = wt_off(fq * 8 + tq, wc * 8 + (tp >> 1)) + 8 * (tp & 1);
  const int nk = K >> 6;
  STAGE_A(0, 0);
  LOAD_W(wr0, 0);
  LOAD_W(wr1, 64);
  WRITE_W(wr0, 0);
  for (int kt = 0; kt < nk; kt += 2) {
    asm volatile("s_waitcnt vmcnt(8)" ::: "memory");
    __syncthreads();
    STAGE_A((kt + 1) << 6, 1);
    if (kt + 2 < nk) LOAD_W(wr0, (kt + 2) << 6);
    COMPUTE(0);
    WRITE_W(wr1, 1);
    if (kt + 2 < nk) { asm volatile("s_waitcnt vmcnt(8)" ::: "memory"); } else { asm volatile("s_waitcnt vmcnt(0)" ::: "memory"); }
    __syncthreads();
    if (kt + 2 < nk) { STAGE_A((kt + 2) << 6, 0); }
    if (kt + 3 < nk) LOAD_W(wr1, (kt + 3) << 6);
    COMPUTE(1);
    if (kt + 2 < nk) WRITE_W(wr0, 0);
  }
#undef STAGE_A
#undef LOAD_W
#undef WRITE_W
#undef COMPUTE
#undef GLDS
#pragma unroll
  for (int mt = 0; mt < 4; mt++) epi(wr * 64 + mt * 16 + fr, wc * 64 + fq * 4, acc[mt]);
}

__device__ __forceinline__ void transpose_tile(const float* __restrict__ src, u16* __restrict__ dst, int R, int C, int tr, int tc, u16* lds) {
  const int t = threadIdx.x;
#pragma unroll
  for (int i = 0; i < 4; i++) {
    int r = (t >> 4) + 16 * i, c4 = (t & 15) * 4;
    float4 v = *(const float4*)(src + (long)(tr * 64 + r) * C + tc * 64 + c4);
    lds[(c4 + 0) * 66 + r] = f2bf(v.x);
    lds[(c4 + 1) * 66 + r] = f2bf(v.y);
    lds[(c4 + 2) * 66 + r] = f2bf(v.z);
    lds[(c4 + 3) * 66 + r] = f2bf(v.w);
  }
  __syncthreads();
  {
    int n = t >> 2, k0 = (t & 3) * 16;
    const uint32_t* s32 = (const uint32_t*)(lds + n * 66 + k0);
    uint4 a, b;
    a.x = s32[0]; a.y = s32[1]; a.z = s32[2]; a.w = s32[3];
    b.x = s32[4]; b.y = s32[5]; b.z = s32[6]; b.w = s32[7];
    u16* d = dst + (long)(tc * 64 + n) * R + tr * 64 + k0;
    *(uint4*)d = a;
    *(uint4*)(d + 8) = b;
  }
  __syncthreads();
}

__device__ void phase_convert(const Params& p, u16* smem) {
  const int nb = gridDim.x, bid = blockIdx.x, t = threadIdx.x;
  if (bid == 0 && t < NEXP) p.cnt()[t * 32] = 0;
  for (int i = bid * 256 + t; i < 9 * 8 * DM; i += nb * 256) {
    int G = i / (8 * DM), rem = i % (8 * DM), e = rem / DM, d = rem % DM;
    if (G == 0) p.wgT()[e * DM + d] = p.w_group[d * 8 + e];
    else p.wrT()[((G - 1) * 8 + e) * DM + d] = p.w_router[((long)(G - 1) * DM + d) * 8 + e];
  }
  {
    const long n4x = (long)SEQ * DM / 4, n4m = (long)MEML * DM / 4;
    for (long i = (long)bid * 256 + t; i < n4x + n4m; i += (long)nb * 256) {
      const float* s; u16* d; long j;
      if (i < n4x) { s = p.x; d = p.xb(); j = i; } else { s = p.mem; d = p.memb(); j = i - n4x; }
      float4 v = *(const float4*)(s + j * 4);
      store_bf4(d + j * 4, v.x, v.y, v.z, v.w);
    }
  }
  const int T_IN = 2560, T_SQ = 1024;
  const int total = T_IN + 5 * T_SQ;
  for (int j = bid; j < total; j += nb) {
    const float* src; u16* dst; int R, C, tl;
    if (j < T_IN) { src = p.w_in; dst = p.WinT(); R = DM; C = INW; tl = j; }
    else {
      int q = (j - T_IN) / T_SQ; tl = (j - T_IN) % T_SQ; R = DM; C = DM;
      src = q == 0 ? p.w_mix_out : q == 1 ? p.mem_w_q : q == 2 ? p.mem_w_k : q == 3 ? p.mem_w_v : p.mem_w_o;
      dst = q == 0 ? p.WmixT() : q == 1 ? p.WqT() : q == 2 ? p.WkT() : q == 3 ? p.WvT() : p.WoT();
    }
    int ntc = C / 64;
    transpose_tile(src, dst, R, C, tl / ntc, tl % ntc, smem);
  }
}

__device__ void phase_inproj(const Params& p, u16* smem) {
  const int MT = SEQ / 128, NT = INW / 128;
  const u16* xb = p.xb(); const u16* WinT = p.WinT(); u16* proj = p.proj();
  gemm_stream(MT * NT, DM, DM, DM, smem,
              [&](int j) { int mt = j % MT, nt = j / MT; TileDesc d; d.A = xb; d.B = WinT + (long)nt * 128 * DM; d.m0 = mt * 128; return d; },
              [&](int j, int m, int nb, f32x4 (&a)[4]) {
                int mt = j % MT, nt = j / MT;
                int seg = nt >> 3;
                u16* outp = proj + (long)(mt * 128 + m) * INW + nt * 128 + nb;
#pragma unroll
                for (int q = 0; q < 4; q++) {
                  float v0 = a[q][0], v1 = a[q][1], v2 = a[q][2], v3 = a[q][3];
                  if (seg < 2) { v0 = gelu_tanh(v0); v1 = gelu_tanh(v1); v2 = gelu_tanh(v2); v3 = gelu_tanh(v3); }
                  else if (seg == 2) { const float sc = 0.08838834764831845f; v0 *= sc; v1 *= sc; v2 *= sc; v3 *= sc; }
                  store_bf4(outp + q * 16, v0, v1, v2, v3);
                }
              });
}

__device__ void memkv_tile(const Params& p, int jj, u16* smem) {
  int which = jj / 32, r_ = jj % 32, mt = r_ & 1, nt = r_ >> 1;
  const u16* W = (which == 0 ? p.WkT() : p.WvT()) + (long)nt * 128 * DM;
  u16* outk = p.kmem() + (long)mt * 128 * DM + nt * 128;
  u16* outv = p.vmemT() + (long)nt * 128 * MEML + mt * 128;
  gemm_tile(p.memb(), DM, nullptr, mt * 128, [&](int r) { return W + (long)r * DM; }, DM, smem,
            [&](int m, int nb, f32x4 (&a)[4]) {
#pragma unroll
              for (int q = 0; q < 4; q++) {
                if (which == 0) store_bf4(outk + (long)m * DM + nb + q * 16, a[q][0], a[q][1], a[q][2], a[q][3]);
                else {
#pragma unroll
                  for (int e = 0; e < 4; e++) outv[(long)(nb + q * 16 + e) * MEML + m] = f2bf(a[q][e]);
                }
              }
            });
  __syncthreads();
}

__device__ void gmlp_item(const Params& p, int nb, int g, u16* smem) {
  const int t = threadIdx.x, lane = t & 63, wid = t >> 6, wr = wid >> 1, wc = wid & 1, fr = lane & 15, fq = lane >> 4;
  u16* sA = smem;
  u16* sB = smem + 16384;
#pragma unroll
  for (int i = 0; i < 8; i++) {
    int q = t + 256 * i;
    int tt = q >> 4, sc = q & 15, kt = sc >> 3, c = sc & 7;
    const float* src = p.gm_w_s + ((long)g * 128 + tt) * 128 + sc * 8;
    float4 a = *(const float4*)src, b = *(const float4*)(src + 4);
    bool keep = (tt >> 6) >= kt;
    uint4 w;
    w.x = keep ? pack2(a.x, a.y) : 0u; w.y = keep ? pack2(a.z, a.w) : 0u;
    w.z = keep ? pack2(b.x, b.y) : 0u; w.w = keep ? pack2(b.z, b.w) : 0u;
    *(uint4*)(sA + kt * 8192 + tt * 64 + ((c ^ ((tt >> 1) & 7)) << 3)) = w;
  }
  {
    const int s = t >> 1, half = t & 1;
    const u16* vp = p.proj() + (long)(nb * 128 + s) * INW + 1024 + g * 128 + half * 64;
    float v[64];
#pragma unroll
    for (int i = 0; i < 8; i++) {
      uint4 w = *(const uint4*)(vp + i * 8);
      v[i * 8 + 0] = bflo(w.x); v[i * 8 + 1] = bfhi(w.x); v[i * 8 + 2] = bflo(w.y); v[i * 8 + 3] = bfhi(w.y);
      v[i * 8 + 4] = bflo(w.z); v[i * 8 + 5] = bfhi(w.z); v[i * 8 + 6] = bflo(w.w); v[i * 8 + 7] = bfhi(w.w);
    }
    float sum = 0.f;
#pragma unroll
    for (int i = 0; i < 64; i++) sum += v[i];
    sum += __shfl_xor(sum, 1);
    const float mean = sum * (1.f / 128.f);
    float sq = 0.f;
#pragma unroll
    for (int i = 0; i < 64; i++) { float d = v[i] - mean; sq += d * d; }
    sq += __shfl_xor(sq, 1);
    const float rstd = rsqrtf(sq * (1.f / 128.f) + 1e-5f);
    const int kt = s >> 6, kk = s & 63;
    const float* lg = p.gm_ln_g + g * 128 + half * 64;
    const float* lb = p.gm_ln_b + g * 128 + half * 64;
#pragma unroll
    for (int i = 0; i < 64; i++) {
      int cc = half * 64 + i;
      float val = (v[i] - mean) * rstd * lg[i] + lb[i];
      sB[kt * 8192 + cc * 64 + (((kk >> 3) ^ ((cc >> 1) & 7)) << 3) + (kk & 7)] = f2bf(val);
    }
  }
  __syncthreads();
  f32x4 acc[4][4];
#pragma unroll
  for (int i = 0; i < 4; i++)
#pragma unroll
    for (int j = 0; j < 4; j++) acc[i][j] = f32x4{0.f, 0.f, 0.f, 0.f};
  mma_128x128x64(sA, sB, acc, wr, wc, fr, fq);
  mma_128x128x64(sA + 8192, sB + 8192, acc, wr, wc, fr, fq);
#pragma unroll
  for (int mt = 0; mt < 4; mt++) {
    int m = wr * 64 + mt * 16 + fr;
    float bs = p.gm_b_s[g * 128 + m];
    const u16* up = p.proj() + (long)(nb * 128 + m) * INW + g * 128;
    u16* op = p.mixcat() + (long)(nb * 128 + m) * DM + g * 128;
#pragma unroll
    for (int nt = 0; nt < 4; nt++) {
      int n = wc * 64 + nt * 16 + fq * 4;
      uint2 uw = *(const uint2*)(up + n);
      f32x4 a = acc[mt][nt];
      store_bf4(op + n, bflo(uw.x) * (a[0] + bs), bfhi(uw.x) * (a[1] + bs), bflo(uw.y) * (a[2] + bs), bfhi(uw.y) * (a[3] + bs));
    }
  }
  __syncthreads();
}

__device__ void attn_item(const Params& p, int h, int qt, u16* smem) {
  u16* sK = smem;
  u16* sP = smem;
  u16* sVt = smem + 8192;
  float* sS = (float*)(smem + 16384);
  const int t = threadIdx.x, lane = t & 63, w = t >> 6, fr = lane & 15, fq = lane >> 4;
  const int q0 = qt * 128;
  const u16* Qb = p.proj() + 2048 + h * 128;
  const u16* Kb = p.proj() + 3072 + h * 128;
  const u16* Vb = p.proj() + 4096 + h * 128;
  f32x4 o[2][8];
#pragma unroll
  for (int i = 0; i < 2; i++)
#pragma unroll
    for (int j = 0; j < 8; j++) o[i][j] = f32x4{0.f, 0.f, 0.f, 0.f};
  const int srow = t >> 1, half = t & 1;
  const int qg = q0 + srow;
  float crow = 0.f;
  for (int kb = qt * 2 + 1; kb >= 0; kb--) {
    bf16x8 qf[2][4];
#pragma unroll
    for (int mt = 0; mt < 2; mt++)
#pragma unroll
      for (int ks = 0; ks < 4; ks++)
        qf[mt][ks] = *(const bf16x8*)(Qb + (long)(q0 + w * 32 + mt * 16 + fr) * INW + ks * 32 + fq * 8);
#pragma unroll
    for (int i = 0; i < 4; i++) {
      int idx = t + 256 * i;
      int key = idx >> 4, ch = idx & 15;
      uint4 kv = *(const uint4*)(Kb + (long)(kb * 64 + key) * INW + ch * 8);
      *(uint4*)(sK + key * 128 + ((ch ^ (key & 15)) << 3)) = kv;
      uint4 vv = *(const uint4*)(Vb + (long)(kb * 64 + key) * INW + ch * 8);
      *(uint4*)((char*)sVt + wt_off(key, ch)) = vv;
    }
    __syncthreads();
#pragma unroll
    for (int nt = 0; nt < 4; nt++) {
      f32x4 s0 = f32x4{0.f, 0.f, 0.f, 0.f}, s1 = f32x4{0.f, 0.f, 0.f, 0.f};
      const int krow = nt * 16 + fr;
#pragma unroll
      for (int ks = 0; ks < 4; ks++) {
        bf16x8 kf = *(const bf16x8*)(sK + krow * 128 + (((ks * 4 + fq) ^ (krow & 15)) << 3));
        s0 = __builtin_amdgcn_mfma_f32_16x16x32_bf16(kf, qf[0][ks], s0, 0, 0, 0);
        s1 = __builtin_amdgcn_mfma_f32_16x16x32_bf16(kf, qf[1][ks], s1, 0, 0, 0);
      }
      *(f32x4*)(sS + (w * 32 + fr) * 68 + nt * 16 + fq * 4) = s0;
      *(f32x4*)(sS + (w * 32 + 16 + fr) * 68 + nt * 16 + fq * 4) = s1;
    }
    __syncthreads();
    {
      float z[32];
      float* srp = sS + srow * 68 + half * 32;
#pragma unroll
      for (int j4 = 0; j4 < 8; j4++) {
        f32x4 v = *(const f32x4*)(srp + j4 * 4);
        z[j4 * 4 + 0] = v[0]; z[j4 * 4 + 1] = v[1]; z[j4 * 4 + 2] = v[2]; z[j4 * 4 + 3] = v[3];
      }
      const int kbase = kb * 64 + half * 32;
      float tot = 0.f;
#pragma unroll
      for (int j4 = 0; j4 < 8; j4++) {
        f32x4 sv;
#pragma unroll
        for (int e = 0; e < 4; e++) {
          const int j = j4 * 4 + e;
          bool valid = (kbase + j) < qg;
          float zz = z[j];
          float s = valid ? (fmaxf(zz, 0.f) + __logf(1.f + __expf(-fabsf(zz)))) : 0.f;
          sv[e] = s;
          tot += s;
          z[j] = zz - s;
        }
        *(f32x4*)(srp + j4 * 4) = sv;
      }
      const float ptot = __shfl_xor(tot, 1);
      float c = crow + (half == 0 ? ptot : 0.f);
#pragma unroll
      for (int j4 = 7; j4 >= 0; j4--) {
        f32x4 sv = *(const f32x4*)(srp + j4 * 4);
#pragma unroll
        for (int e = 3; e >= 0; e--) {
          const int j = j4 * 4 + e;
          bool valid = (kbase + j) < qg;
          float a = valid ? __expf(z[j] - c) : 0.f;
          c += sv[e];
          z[j] = a;
        }
      }
      crow += tot + ptot;
#pragma unroll
      for (int q = 0; q < 4; q++) {
        uint4 wv;
        wv.x = pack2(z[q * 8 + 0], z[q * 8 + 1]); wv.y = pack2(z[q * 8 + 2], z[q * 8 + 3]);
        wv.z = pack2(z[q * 8 + 4], z[q * 8 + 5]); wv.w = pack2(z[q * 8 + 6], z[q * 8 + 7]);
        *(uint4*)(sP + srow * 64 + (((half * 4 + q) ^ ((srow >> 1) & 7)) << 3)) = wv;
      }
    }
    const int done = __syncthreads_and(crow > SB_THRESH);
#pragma unroll
    for (int ks = 0; ks < 2; ks++) {
      bf16x8 pf[2];
#pragma unroll
      for (int mt = 0; mt < 2; mt++) {
        int row = w * 32 + mt * 16 + fr;
        pf[mt] = *(const bf16x8*)(sP + row * 64 + (((ks * 4 + fq) ^ ((row >> 1) & 7)) << 3));
      }
#pragma unroll
      for (int nt = 0; nt < 8; nt++) {
        const int vk0 = ks * 32 + fq * 8 + (fr >> 2), vc = nt * 2 + ((fr & 3) >> 1), vb8 = 8 * (fr & 1);
        s16x4 vlo = __builtin_amdgcn_ds_read_tr16_b64_v4i16((s16x4 LAS*)((const char*)sVt + wt_off(vk0, vc) + vb8));
        s16x4 vhi = __builtin_amdgcn_ds_read_tr16_b64_v4i16((s16x4 LAS*)((const char*)sVt + wt_off(vk0 + 4, vc) + vb8));
        bf16x8 vf = bf16x8{vlo[0], vlo[1], vlo[2], vlo[3], vhi[0], vhi[1], vhi[2], vhi[3]};
        o[0][nt] = __builtin_amdgcn_mfma_f32_16x16x32_bf16(vf, pf[0], o[0][nt], 0, 0, 0);
        o[1][nt] = __builtin_amdgcn_mfma_f32_16x16x32_bf16(vf, pf[1], o[1][nt], 0, 0, 0);
      }
    }
    __syncthreads();
    if (done) break;
  }
#pragma unroll
  for (int mt = 0; mt < 2; mt++) {
    u16* op = p.mixcat() + (long)(q0 + w * 32 + mt * 16 + fr) * DM + 1024 + h * 128;
#pragma unroll
    for (int nt = 0; nt < 8; nt++) {
      f32x4 a = o[mt][nt];
      store_bf4(op + nt * 16 + fq * 4, a[0], a[1], a[2], a[3]);
    }
  }
}

__device__ void phase_mix(const Params& p, u16* smem) {
  const int NA = 8 * 64, NG = 64 * 8;
#ifndef NO_ATTN
  for (int j = blockIdx.x; j < NA; j += gridDim.x) { int qt = 63 - (j >> 3), h = j & 7; attn_item(p, h, qt, smem); }
#endif
#ifndef NO_GMLP
  for (int j = blockIdx.x; j < NG; j += gridDim.x) gmlp_item(p, j >> 3, j & 7, smem);
#endif
  for (int j = gridDim.x - 1 - blockIdx.x; j < 64; j += gridDim.x) memkv_tile(p, j, smem);
}

template <bool RES_BF16>
__device__ __forceinline__ void gemm_residual(const u16* A, const u16* WT, const void* res_, float* pre, u16* smem) {
  const int MT = SEQ / 128, NT = DM / 128;
  gemm_stream(MT * NT, DM, DM, DM, smem,
              [&](int j) { int mt = j % MT, nt = j / MT; TileDesc d; d.A = A; d.B = WT + (long)nt * 128 * DM; d.m0 = mt * 128; return d; },
              [&](int j, int m, int nb, f32x4 (&a)[4]) {
                int mt = j % MT, nt = j / MT;
                const long off = (long)(mt * 128 + m) * DM + nt * 128 + nb;
#pragma unroll
                for (int q = 0; q < 4; q++) {
                  float4 xv;
                  if (RES_BF16) {
                    uint2 xw = *(const uint2*)((const u16*)res_ + off + q * 16);
                    xv.x = bflo(xw.x); xv.y = bfhi(xw.x); xv.z = bflo(xw.y); xv.w = bfhi(xw.y);
                  } else {
                    xv = *(const float4*)((const float*)res_ + off + q * 16);
                  }
                  float4 r; r.x = DN_ALPHA * xv.x + a[q][0]; r.y = DN_ALPHA * xv.y + a[q][1]; r.z = DN_ALPHA * xv.z + a[q][2]; r.w = DN_ALPHA * xv.w + a[q][3];
                  *(float4*)(pre + off + q * 16) = r;
                }
              });
}
__device__ void phase_mixout(const Params& p, u16* smem) { gemm_residual<false>(p.mixcat(), p.WmixT(), p.x, p.pre(), smem); }
__device__ void phase_oproj(const Params& p, u16* smem) { gemm_residual<true>(p.om(), p.WoT(), p.hb(), p.pre(), smem); }

__device__ void phase_qproj(const Params& p, u16* smem) {
  const int MT = SEQ / 128, NT = DM / 128;
  const u16* hb = p.hb(); const u16* WqT = p.WqT(); u16* qm = p.qm();
  gemm_stream(MT * NT, DM, DM, DM, smem,
              [&](int j) { int mt = j % MT, nt = j / MT; TileDesc d; d.A = hb; d.B = WqT + (long)nt * 128 * DM; d.m0 = mt * 128; return d; },
              [&](int j, int m, int nb, f32x4 (&a)[4]) {
                int mt = j % MT, nt = j / MT;
                u16* outp = qm + (long)(mt * 128 + m) * DM + nt * 128 + nb;
                const float sc = 0.04419417382415922f;
#pragma unroll
                for (int q = 0; q < 4; q++) store_bf4(outp + q * 16, a[q][0] * sc, a[q][1] * sc, a[q][2] * sc, a[q][3] * sc);
              });
}

__device__ void phase_scores(const Params& p, u16* smem) {
  const int MT = SEQ / 128;
  const u16* qm = p.qm(); const u16* kmem = p.kmem(); float* scores = p.scores();
  gemm_stream(4 * MT * 2, DM, DM, 512, smem,
              [&](int j) { int mt = j % MT, r_ = j / MT, nt = r_ & 1, h = r_ >> 1; TileDesc d; d.A = qm + h * 512; d.B = kmem + (long)nt * 128 * DM + h * 512; d.m0 = mt * 128; return d; },
              [&](int j, int m, int nb, f32x4 (&a)[4]) {
                int mt = j % MT, r_ = j / MT, nt = r_ & 1, h = r_ >> 1;
                float* outp = scores + ((long)h * SEQ + mt * 128 + m) * MEML + nt * 128 + nb;
#pragma unroll
                for (int q = 0; q < 4; q++) {
                  float4 r4; r4.x = a[q][0]; r4.y = a[q][1]; r4.z = a[q][2]; r4.w = a[q][3];
                  *(float4*)(outp + q * 16) = r4;
                }
              });
}

__device__ void phase_softmax(const Params& p) {
  const int wpb = 4, lane = threadIdx.x & 63, wid = threadIdx.x >> 6;
  const int nrows = 4 * SEQ;
  for (int r = blockIdx.x * wpb + wid; r < nrows; r += gridDim.x * wpb) {
    float4 v = *(const float4*)(p.scores() + (long)r * MEML + lane * 4);
    float mx = wave_max(fmaxf(fmaxf(v.x, v.y), fmaxf(v.z, v.w)));
    float e0 = __expf(v.x - mx), e1 = __expf(v.y - mx), e2 = __expf(v.z - mx), e3 = __expf(v.w - mx);
    float inv = 1.f / wave_sum(e0 + e1 + e2 + e3);
    store_bf4(p.Pm() + (long)r * MEML + lane * 4, e0 * inv, e1 * inv, e2 * inv, e3 * inv);
  }
}

__device__ void phase_pv(const Params& p, u16* smem) {
  const int MT = SEQ / 128;
  const u16* Pm = p.Pm(); const u16* vmemT = p.vmemT(); u16* om = p.om();
  gemm_stream(4 * MT * 4, MEML, MEML, MEML, smem,
              [&](int j) { int mt = j % MT, r_ = j / MT, nt = r_ & 3, h = r_ >> 2; TileDesc d; d.A = Pm + (long)h * SEQ * MEML; d.B = vmemT + (long)(h * 512 + nt * 128) * MEML; d.m0 = mt * 128; return d; },
              [&](int j, int m, int nb, f32x4 (&a)[4]) {
                int mt = j % MT, r_ = j / MT, nt = r_ & 3, h = r_ >> 2;
                u16* outp = om + (long)(mt * 128 + m) * DM + h * 512 + nt * 128 + nb;
#pragma unroll
                for (int q = 0; q < 4; q++) store_bf4(outp + q * 16, a[q][0], a[q][1], a[q][2], a[q][3]);
              });
}

__device__ __forceinline__ void ln_stats(const float (&v)[32], float& mean, float& rstd) {
  float s = 0.f;
#pragma unroll
  for (int i = 0; i < 32; i++) s += v[i];
  mean = wave_sum(s) * (1.f / DM);
  float q = 0.f;
#pragma unroll
  for (int i = 0; i < 32; i++) { float d = v[i] - mean; q += d * d; }
  rstd = rsqrtf(wave_sum(q) * (1.f / DM) + 1e-5f);
}

typedef const f32x4 __attribute__((address_space(1)))* g_cv4;
typedef f32x4 __attribute__((address_space(1)))* g_v4;
typedef unsigned int u32x2 __attribute__((ext_vector_type(2)));
typedef const u32x2 __attribute__((address_space(1)))* g_cu2;
typedef u32x2 __attribute__((address_space(1)))* g_u2;
template <class G, class T> __device__ __forceinline__ G opaque_g(T* q) { asm volatile("" : "+v"(q)); return (G)q; }

template <int MODE>
__device__ void phase_ln(const Params& p, u16* smem) {
  const int lane = threadIdx.x & 63, wid = threadIdx.x >> 6;
  const float* gam = MODE == 0 ? p.ln1_g : p.ln3_g;
  const float* bet = MODE == 0 ? p.ln1_b : p.ln3_b;
  for (int rb = (blockIdx.x * 4 + wid) * 2; rb < SEQ; rb += gridDim.x * 8) {
    float v[2][32];
#pragma unroll
    for (int q = 0; q < 2; q++) {
      const int r = rb + q;
      if (MODE == 0) {
        g_cv4 pr = opaque_g<g_cv4>(p.pre() + (long)r * DM + lane * 4);
#pragma unroll
        for (int i = 0; i < 8; i++) {
          f32x4 a = pr[i * 64];
          v[q][i * 4 + 0] = a[0]; v[q][i * 4 + 1] = a[1]; v[q][i * 4 + 2] = a[2]; v[q][i * 4 + 3] = a[3];
        }
      } else {
        g_cu2 ph = opaque_g<g_cu2>(p.hb() + (long)r * DM + lane * 4);
        g_cu2 py0 = opaque_g<g_cu2>(p.yslot() + (long)(2 * r) * DM + lane * 4);
        g_cu2 py1 = opaque_g<g_cu2>(p.yslot() + (long)(2 * r + 1) * DM + lane * 4);
#pragma unroll
        for (int i = 0; i < 8; i++) {
          u32x2 hw = ph[i * 64], y0 = py0[i * 64], y1 = py1[i * 64];
          v[q][i * 4 + 0] = DN_ALPHA * bflo(hw[0]) + (bflo(y0[0]) + bflo(y1[0]));
          v[q][i * 4 + 1] = DN_ALPHA * bfhi(hw[0]) + (bfhi(y0[0]) + bfhi(y1[0]));
          v[q][i * 4 + 2] = DN_ALPHA * bflo(hw[1]) + (bflo(y0[1]) + bflo(y1[1]));
          v[q][i * 4 + 3] = DN_ALPHA * bfhi(hw[1]) + (bfhi(y0[1]) + bfhi(y1[1]));
        }
      }
    }
    float mean[2], rstd[2];
    ln_stats(v[0], mean[0], rstd[0]);
    ln_stats(v[1], mean[1], rstd[1]);
    g_cv4 pg = opaque_g<g_cv4>(gam + lane * 4);
    g_cv4 pb = opaque_g<g_cv4>(bet + lane * 4);
#pragma unroll
    for (int q = 0; q < 2; q++) {
      g_v4 po = opaque_g<g_v4>(p.out + (long)(rb + q) * DM + lane * 4);
      g_u2 ph = opaque_g<g_u2>(p.hb() + (long)(rb + q) * DM + lane * 4);
#pragma unroll
      for (int i = 0; i < 8; i++) {
        f32x4 g = pg[i * 64], b = pb[i * 64];
        f32x4 o4;
#pragma unroll
        for (int e = 0; e < 4; e++) o4[e] = (v[q][i * 4 + e] - mean[q]) * rstd[q] * g[e] + b[e];
        if (MODE == 2) po[i * 64] = o4;
        else { u32x2 w = {pack2(o4[0], o4[1]), pack2(o4[2], o4[3])}; ph[i * 64] = w; }
      }
    }
  }
}

typedef const f32x4 __attribute__((address_space(1)))* gv4p;
__device__ __forceinline__ gv4p launder_g(const float* q) { asm volatile("" : "+v"(q)); return (gv4p)q; }

__device__ __forceinline__ void wave_reduce8(float (&a)[8], int lane) {
  float b[4], c[2], d;
  const bool h5 = lane & 32, h4 = lane & 16, h3 = lane & 8;
#pragma unroll
  for (int k = 0; k < 4; k++) {
    float send = h5 ? a[k] : a[k + 4];
    float keep = h5 ? a[k + 4] : a[k];
    b[k] = keep + __shfl_xor(send, 32);
  }
#pragma unroll
  for (int k = 0; k < 2; k++) {
    float send = h4 ? b[k] : b[k + 2];
    float keep = h4 ? b[k + 2] : b[k];
    c[k] = keep + __shfl_xor(send, 16);
  }
  {
    float send = h3 ? c[0] : c[1];
    float keep = h3 ? c[1] : c[0];
    d = keep + __shfl_xor(send, 8);
  }
  d += __shfl_xor(d, 4);
  d += __shfl_xor(d, 2);
  d += __shfl_xor(d, 1);
#pragma unroll
  for (int g = 0; g < 8; g++) a[g] = __shfl(d, ((g >> 2) & 1) * 32 + ((g >> 1) & 1) * 16 + (g & 1) * 8);
}

__device__ void phase_ln2_route(const Params& p) {
  const int lane = threadIdx.x & 63, wid = threadIdx.x >> 6;
  const float* wgT = p.wgT();
  const float* wrT = p.wrT();
#define CH(i) ((i) * 256)
  for (int rb = (blockIdx.x * 4 + wid) * 2; rb < SEQ; rb += gridDim.x * 8) {
    float v[2][32];
#pragma unroll
    for (int q = 0; q < 2; q++)
#pragma unroll
      for (int i = 0; i < 8; i++) {
        f32x4 a = *(const f32x4*)(p.pre() + (long)(rb + q) * DM + CH(i) + lane * 4);
        v[q][i * 4 + 0] = a[0]; v[q][i * 4 + 1] = a[1]; v[q][i * 4 + 2] = a[2]; v[q][i * 4 + 3] = a[3];
      }
    float mean[2], rstd[2];
    ln_stats(v[0], mean[0], rstd[0]);
    ln_stats(v[1], mean[1], rstd[1]);
#pragma unroll
    for (int i = 0; i < 8; i++) {
      int c = CH(i) + lane * 4;
      f32x4 g = *(const f32x4*)(p.ln2_g + c), b = *(const f32x4*)(p.ln2_b + c);
#pragma unroll
      for (int q = 0; q < 2; q++) {
        f32x4 o4;
#pragma unroll
        for (int e = 0; e < 4; e++) { o4[e] = (v[q][i * 4 + e] - mean[q]) * rstd[q] * g[e] + b[e]; v[q][i * 4 + e] = o4[e]; }
        store_bf4(p.hb() + (long)(rb + q) * DM + c, o4[0], o4[1], o4[2], o4[3]);
      }
    }
    float lg[2][8];
    {
      f32x4 wb[2][8];
      {
        gv4p wp = launder_g(wgT + lane * 4);
#pragma unroll
        for (int i = 0; i < 8; i++) wb[0][i] = wp[CH(i) >> 2];
      }
#pragma unroll
      for (int g = 0; g < 8; g++) {
        if (g + 1 < 8) {
          gv4p wp = launder_g(wgT + (g + 1) * DM + lane * 4);
#pragma unroll
          for (int i = 0; i < 8; i++) wb[(g + 1) & 1][i] = wp[CH(i) >> 2];
        }
        __builtin_amdgcn_sched_barrier(0);
        float s0 = 0.f, s1 = 0.f;
#pragma unroll
        for (int i = 0; i < 8; i++)
#pragma unroll
          for (int e = 0; e < 4; e++) { s0 += wb[g & 1][i][e] * v[0][i * 4 + e]; s1 += wb[g & 1][i][e] * v[1][i * 4 + e]; }
        lg[0][g] = s0; lg[1][g] = s1;
        __builtin_amdgcn_sched_barrier(0);
      }
    }
    wave_reduce8(lg[0], lane);
    wave_reduce8(lg[1], lane);
    int gi[2]; float gval[2];
#pragma unroll
    for (int q = 0; q < 2; q++) {
#pragma unroll
      for (int g = 0; g < 8; g++) lg[q][g] += p.b_group[g];
      int bi = 0; float gm = lg[q][0];
#pragma unroll
      for (int g = 1; g < 8; g++) if (lg[q][g] > gm) { gm = lg[q][g]; bi = g; }
      float gs = 0.f;
#pragma unroll
      for (int g = 0; g < 8; g++) gs += __expf(lg[q][g] - gm);
      gval[q] = 1.f / gs;
      gi[q] = __builtin_amdgcn_readfirstlane(bi);
    }
    float le[2][8];
    {
      const float* wr0_ = wrT + (long)gi[0] * 8 * DM;
      const float* wr1_ = wrT + (long)gi[1] * 8 * DM;
      f32x4 wb[2][8];
      {
        gv4p wp = launder_g(wr0_ + lane * 4);
#pragma unroll
        for (int i = 0; i < 8; i++) wb[0][i] = wp[CH(i) >> 2];
      }
#pragma unroll
      for (int u = 0; u < 16; u++) {
        if (u + 1 < 16) {
          gv4p wp = launder_g((((u + 1) >> 3) ? wr1_ : wr0_) + ((u + 1) & 7) * DM + lane * 4);
#pragma unroll
          for (int i = 0; i < 8; i++) wb[(u + 1) & 1][i] = wp[CH(i) >> 2];
        }
        __builtin_amdgcn_sched_barrier(0);
        float s0 = 0.f;
#pragma unroll
        for (int i = 0; i < 8; i++)
#pragma unroll
          for (int e = 0; e < 4; e++) s0 += wb[u & 1][i][e] * v[u >> 3][i * 4 + e];
        le[u >> 3][u & 7] = s0;
        __builtin_amdgcn_sched_barrier(0);
      }
    }
    wave_reduce8(le[0], lane);
    wave_reduce8(le[1], lane);
#pragma unroll
    for (int q = 0; q < 2; q++) {
#pragma unroll
      for (int g = 0; g < 8; g++) le[q][g] += p.b_router[gi[q] * 8 + g];
      int i1 = 0; float v1 = le[q][0];
#pragma unroll
      for (int g = 1; g < 8; g++) if (le[q][g] > v1) { v1 = le[q][g]; i1 = g; }
      int i2 = 0; float v2 = -3.0e38f;
#pragma unroll
      for (int g = 0; g < 8; g++) if (g != i1 && le[q][g] > v2) { v2 = le[q][g]; i2 = g; }
      float e2 = __expf(v2 - v1);
      float g1 = gval[q] / (1.f + e2), g2 = gval[q] * e2 / (1.f + e2);
      if (lane == 0) {
        const int r = rb + q;
        int ea = gi[q] * 8 + i1, eb = gi[q] * 8 + i2;
        int pa = atomicAdd(&p.cnt()[ea * 32], 1);
        p.rowlist()[ea * SEQ + pa] = 2 * r;
        p.gates()[2 * r] = g1;
        int pb = atomicAdd(&p.cnt()[eb * 32], 1);
        p.rowlist()[eb * SEQ + pb] = 2 * r + 1;
        p.gates()[2 * r + 1] = g2;
      }
    }
  }
}
#undef CH

template <int STAGE>
__device__ void phase_moe(const Params& p, u16* smem) {
  int* sInfo = (int*)(smem + 32768);
  int* sPref = sInfo;
  int* sArow = sInfo + 128;
  int* sAsg = sInfo + 256;
  const int t = threadIdx.x;
  const int xg = (gridDim.x >= 8) ? (int)(blockIdx.x & 7) : 0;
  const int ngrp = (gridDim.x >= 8) ? 8 : 1;
  const int lb = (gridDim.x >= 8) ? (int)(blockIdx.x >> 3) : (int)blockIdx.x;
  const int nlb = (gridDim.x >= 8) ? (int)((gridDim.x - xg + 7) >> 3) : (int)gridDim.x;
  const int nex = NEXP / ngrp;
  if (t == 0) {
    int acc = 0;
    for (int q = 0; q < nex; q++) { sPref[q] = acc; acc += (p.cnt()[(xg + ngrp * q) * 32] + 127) >> 7; }
    sPref[nex] = acc;
  }
  __syncthreads();
  const int NT = STAGE == 0 ? (DEXP / 64) : (DM / 128);
  const int total = sPref[nex] * NT;
  for (int j = lb; j < total; j += nlb) {
    int nt = j % NT, mg = j / NT;
    int eq = 0;
    for (int q = 0; q < nex; q++) if (sPref[q + 1] <= mg) eq = q + 1;
    int mt = mg - sPref[eq];
    const int e = xg + ngrp * eq;
    int ce = p.cnt()[e * 32];
    if (t < 128) {
      int idx = mt * 128 + t;
      int a = idx < ce ? p.rowlist()[e * SEQ + idx] : -1;
      sAsg[t] = a;
      sArow[t] = a < 0 ? 0 : (STAGE == 0 ? (a >> 1) : a);
    }
    __syncthreads();
    if (STAGE == 0) {
      const float* W1 = p.w1 + (long)e * DM * DEXP + nt * 64;
      const float* W3 = p.w3 + (long)e * DM * DEXP + nt * 64;
      u16* hidp = p.hid() + nt * 64;
      gemm_tile_wf32(p.hb(), DM, sArow,
                [&](int& k, int& v, const float*& src) {
                  int which = (t >> 4) & 1;
                  k = t >> 5;
                  int c4 = (t & 15) * 4;
                  v = (c4 >> 4) * 32 + which * 16 + (c4 & 15);
                  src = (which ? W3 : W1) + (long)k * DEXP + c4;
                }, DEXP, DM, smem,
                [&](int m, int nb, f32x4 (&a)[4]) {
                  int as = sAsg[m];
                  if (as >= 0) {
                    int wc = nb >> 6, f4 = nb & 63;
#pragma unroll
                    for (int q = 0; q < 2; q++) {
                      f32x4 g = a[2 * q], u = a[2 * q + 1];
                      float r0 = g[0] / (1.f + __expf(-g[0])) * u[0];
                      float r1 = g[1] / (1.f + __expf(-g[1])) * u[1];
                      float r2 = g[2] / (1.f + __expf(-g[2])) * u[2];
                      float r3 = g[3] / (1.f + __expf(-g[3])) * u[3];
                      store_bf4(hidp + (long)as * DEXP + (wc * 2 + q) * 16 + f4, r0, r1, r2, r3);
                    }
                  }
                });
    } else {
      const float* W2 = p.w2 + (long)e * DEXP * DM + nt * 128;
      u16* yp = p.yslot() + nt * 128;
      const float* gp = p.gates();
      gemm_tile_wf32(p.hid(), DEXP, sArow,
                [&](int& k, int& v, const float*& src) {
                  k = t >> 5;
                  v = (t & 31) * 4;
                  src = W2 + (long)k * DM + v;
                }, DM, DEXP, smem,
                [&](int m, int nb, f32x4 (&a)[4]) {
                  int as = sAsg[m];
                  if (as >= 0) {
                    float gt = gp[as];
#pragma unroll
                    for (int q = 0; q < 4; q++) store_bf4(yp + (long)as * DM + nb + q * 16, gt * a[q][0], gt * a[q][1], gt * a[q][2], gt * a[q][3]);
                  }
                });
    }
    __syncthreads();
  }
}


#define XB_TMO      128
#define XB_XCNT(j)  (256  + 64 * (j))
#define XB_XSUB(j)  (1280 + 64 * (j))
#define XB_XGEN(j)  (2304 + 64 * (j))
#define XB_TOP      3328
#define XB_TOPGEN   3392
#define XCD_BAR_WORDS 3456
#define XB_SPIN_CAP (1u << 22)
__device__ __forceinline__ unsigned xb_ld(unsigned* p) { return __hip_atomic_load(p, __ATOMIC_RELAXED, __HIP_MEMORY_SCOPE_AGENT); }
__device__ __forceinline__ unsigned xb_add(unsigned* p, unsigned v) { return __hip_atomic_fetch_add(p, v, __ATOMIC_RELAXED, __HIP_MEMORY_SCOPE_AGENT); }
__device__ __forceinline__ unsigned xb_xcc_id() { return (unsigned)__builtin_amdgcn_s_getreg((3 << 11) | 20) & 0xFu; }
#define XB_SPIN(cond, bar) do { unsigned _sp = 0; while (cond) { __builtin_amdgcn_s_sleep(1); \
    if ((++_sp & 255u) == 0u) { if (xb_ld(&(bar)[XB_TMO])) break; if (_sp > XB_SPIN_CAP) { atomicAdd(&(bar)[XB_TMO], 1u); break; } } } } while (0)
struct XcdBarrier { unsigned* bar; unsigned x; volatile LAS unsigned* st; };
__device__ __forceinline__ XcdBarrier xcd_barrier_post(unsigned* bar, volatile LAS unsigned* st) {
  XcdBarrier b; b.bar = bar; b.x = xb_xcc_id(); b.st = st;
  if (threadIdx.x == 0) (void)xb_add(&bar[XB_XCNT(b.x)], 1u);
  return b;
}
__device__ __forceinline__ void xcd_barrier_complete(unsigned* bar, unsigned x, unsigned& nloc, unsigned& nx) {
  const unsigned G = gridDim.x;
  unsigned sum, cnt, mine, sp = 0u;
  for (;;) {
    sum = 0u; cnt = 0u; mine = 0u;
#pragma unroll
    for (unsigned j = 0; j < 16; ++j) { const unsigned c = xb_ld(&bar[XB_XCNT(j)]); sum += c; cnt += (c > 0u) ? 1u : 0u; mine = (j == x) ? c : mine; }
    if (sum == G) break;
    __builtin_amdgcn_s_sleep(1);
    if ((++sp & 255u) == 0u) { if (xb_ld(&bar[XB_TMO])) break; if (sp > XB_SPIN_CAP) { atomicAdd(&bar[XB_TMO], 1u); break; } }
  }
  nloc = mine > 0u ? mine : 1u; nx = cnt > 0u ? cnt : 1u;
}
__device__ __forceinline__ void xcd_barrier(const XcdBarrier& b) {
  asm volatile("s_waitcnt vmcnt(0)" ::: "memory");
  __syncthreads();
  if (threadIdx.x == 0) {
    unsigned* bar = b.bar;
    __builtin_amdgcn_s_waitcnt(0);
    unsigned nloc = b.st[0], nx = b.st[1];
    if (nloc == 0u) { xcd_barrier_complete(bar, b.x, nloc, nx); b.st[0] = nloc; b.st[1] = nx; }
    const unsigned old = xb_add(&bar[XB_XSUB(b.x)], 1u);
    const unsigned gen = old / nloc;
    if (old + 1u == (gen + 1u) * nloc) {
      __builtin_amdgcn_fence(__ATOMIC_RELEASE, "agent");
      asm volatile("s_waitcnt vmcnt(0)" ::: "memory");
      const unsigned og = xb_add(&bar[XB_TOP], 1u);
      const unsigned tg = og / nx;
      if (og + 1u == (tg + 1u) * nx) xb_add(&bar[XB_TOPGEN], 1u);
      else XB_SPIN(xb_ld(&bar[XB_TOPGEN]) == tg, bar);
      __builtin_amdgcn_fence(__ATOMIC_ACQUIRE, "agent");
      xb_add(&bar[XB_XGEN(b.x)], 1u);
      asm volatile("s_waitcnt vmcnt(0)" ::: "memory");
    } else {
      XB_SPIN(xb_ld(&bar[XB_XGEN(b.x)]) == gen, bar);
      __builtin_amdgcn_fence(__ATOMIC_ACQUIRE, "agent");
      asm volatile("s_waitcnt vmcnt(0)" ::: "memory");
    }
  }
  __syncthreads();
}

constexpr int NPH = 14;
__device__ __forceinline__ void run_phase(const Params& p, int ph, u16* smem) {
  switch (ph) {
    case 0: phase_convert(p, smem); break;
    case 1: phase_inproj(p, smem); break;
    case 2: phase_mix(p, smem); break;
    case 3: phase_mixout(p, smem); break;
    case 4: phase_ln<0>(p, smem); break;
    case 5: phase_qproj(p, smem); break;
    case 6: phase_scores(p, smem); break;
    case 7: phase_softmax(p); break;
    case 8: phase_pv(p, smem); break;
    case 9: phase_oproj(p, smem); break;
    case 10: phase_ln2_route(p); break;
    case 11: phase_moe<0>(p, smem); break;
    case 12: phase_moe<1>(p, smem); break;
    case 13: phase_ln<2>(p, smem); break;
  }
}

__global__ void __launch_bounds__(256, 2) mega_kernel(Params p) {
  extern __shared__ __attribute__((aligned(16))) u16 smem[];
  __shared__ uint4 xb_words;
  cg::grid_group grid = cg::this_grid();
  if (threadIdx.x == 0) xb_words = make_uint4(0u, 0u, 0u, 0u);
  __syncthreads();
  const XcdBarrier xb = xcd_barrier_post(p.bar(), (volatile LAS unsigned*)&xb_words);
  if (p.ws == nullptr) grid.sync();
#define GSYNC() xcd_barrier(xb)
#ifdef ONLY_PH
  run_phase(p, ONLY_PH, smem); GSYNC();
  return;
#endif
  run_phase(p, 0, smem); GSYNC();
  run_phase(p, 1, smem); GSYNC();
  run_phase(p, 2, smem); GSYNC();
  run_phase(p, 3, smem); GSYNC();
  run_phase(p, 4, smem); GSYNC();
  run_phase(p, 5, smem); GSYNC();
  run_phase(p, 6, smem); GSYNC();
  run_phase(p, 7, smem); GSYNC();
  run_phase(p, 8, smem); GSYNC();
  run_phase(p, 9, smem); GSYNC();
  run_phase(p, 10, smem); GSYNC();
  run_phase(p, 11, smem); GSYNC();
  run_phase(p, 12, smem); GSYNC();
  run_phase(p, 13, smem);
}

extern "C" void kernel_launch(void* const* d_in, const int* in_sizes, int n_in, void* d_out, int out_size, void* d_ws,
                              size_t ws_size, hipStream_t stream) {
  static int grid_blocks = 0;
  if (!grid_blocks) {
    int dev = 0, cus = 0, per_cu = 0;
    hipGetDevice(&dev);
    hipDeviceGetAttribute(&cus, hipDeviceAttributeMultiprocessorCount, dev);
    hipFuncSetAttribute((const void*)mega_kernel, hipFuncAttributeMaxDynamicSharedMemorySize, LDS_BYTES);
    hipOccupancyMaxActiveBlocksPerMultiprocessor(&per_cu, (const void*)mega_kernel, 256, LDS_BYTES);
    if (per_cu < 1) per_cu = 1;
    if (per_cu > 2) per_cu = 2;
    grid_blocks = cus * per_cu;
  }
  Params p{};
  const float* const* in = (const float* const*)d_in;
  p.x = in[0]; p.mem = in[1]; p.w_in = in[2]; p.gm_ln_g = in[3]; p.gm_ln_b = in[4]; p.gm_w_s = in[5]; p.gm_b_s = in[6];
  p.w_mix_out = in[7]; p.ln1_g = in[8]; p.ln1_b = in[9]; p.mem_w_q = in[10]; p.mem_w_k = in[11]; p.mem_w_v = in[12];
  p.mem_w_o = in[13]; p.ln2_g = in[14]; p.ln2_b = in[15]; p.w_group = in[16]; p.b_group = in[17]; p.w_router = in[18];
  p.b_router = in[19]; p.w1 = in[20]; p.w3 = in[21]; p.w2 = in[22]; p.ln3_g = in[23]; p.ln3_b = in[24];
  p.out = (float*)d_out;
  p.ws = (char*)d_ws;
  if (ws_size < 756 * MB) { fprintf(stderr, "workspace too small: %zu\n", ws_size); return; }
  hipMemsetAsync((char*)d_ws + 754 * MB, 0, XCD_BAR_WORDS * sizeof(unsigned), stream);
  void* args[] = {&p};
  hipError_t e = hipLaunchCooperativeKernel((const void*)mega_kernel, dim3(grid_blocks), dim3(256), args, LDS_BYTES, stream);
  if (e != hipSuccess) fprintf(stderr, "cooperative launch failed: %s (grid %d)\n", hipGetErrorString(e), grid_blocks);
}
```

```cpp
#include <hip/hip_runtime.h>
#include <hip/hip_cooperative_groups.h>
#include <stdint.h>
#include <stdio.h>
namespace cg = cooperative_groups;

typedef unsigned short u16;
using bf16x8 = __attribute__((ext_vector_type(8))) short;
using f32x4 = __attribute__((ext_vector_type(4))) float;
using u32x4 = __attribute__((ext_vector_type(4))) unsigned int;
#define LAS __attribute__((address_space(3)))

constexpr int SEQ = 8192, DM = 2048, INW = 5120, MEML = 256;
constexpr int NEXP = 64, DEXP = 512;
constexpr float DN_ALPHA = 1.189207115002721f;
constexpr float SB_THRESH = 40.f;
constexpr int LDS_BYTES = 73728;
constexpr size_t MB = 1u << 20;

struct Params {
  const float *x, *mem, *w_in, *gm_ln_g, *gm_ln_b, *gm_w_s, *gm_b_s, *w_mix_out, *ln1_g, *ln1_b;
  const float *mem_w_q, *mem_w_k, *mem_w_v, *mem_w_o, *ln2_g, *ln2_b, *w_group, *b_group, *w_router, *b_router;
  const float *w1, *w3, *w2, *ln3_g, *ln3_b;
  float* out;
  char* ws;
#define WSP(T, name, offmb) __device__ __forceinline__ T* name() const { return (T*)(ws + (size_t)(offmb) * MB); }
  WSP(u16, WinT, 0) WSP(u16, WmixT, 20) WSP(u16, WqT, 28) WSP(u16, WkT, 36) WSP(u16, WvT, 44) WSP(u16, WoT, 52)
  WSP(u16, W1T, 60) WSP(u16, W3T, 188) WSP(u16, W2T, 316)
  WSP(u16, xb, 444)
  WSP(float, scores, 444)
  WSP(u16, memb, 476) WSP(u16, kmem, 477) WSP(u16, vmemT, 478)
  WSP(u16, proj, 479)
  WSP(u16, qm, 479)
  WSP(u16, om, 511)
  WSP(u16, yslot, 479)
  WSP(u16, mixcat, 559)
  WSP(u16, Pm, 559)
  WSP(u16, hid, 575)
  WSP(float, pre, 591)
  WSP(float, hf, 655)
  WSP(u16, hb, 719)
  WSP(int, cnt, 751)
  __device__ __forceinline__ float* gates() const { return (float*)(ws + 751 * MB + 65536); }
  WSP(int, rowlist, 752)
  WSP(unsigned, bar, 754)
  WSP(float, wgT, 755)
  __device__ __forceinline__ float* wrT() const { return (float*)(ws + 755 * MB + 65536); }
};

__device__ __forceinline__ uint32_t pack2(float a, float b);
__device__ __forceinline__ u16 f2bf(float f) { return (u16)(pack2(f, f) & 0xffffu); }
__device__ __forceinline__ float bflo(uint32_t w) { return __uint_as_float(w << 16); }
__device__ __forceinline__ float bfhi(uint32_t w) { return __uint_as_float(w & 0xffff0000u); }
typedef float f32x2_t __attribute__((ext_vector_type(2)));
typedef __bf16 bf16x2_t __attribute__((ext_vector_type(2)));
__device__ __forceinline__ uint32_t pack2(float a, float b) {
  f32x2_t v = {a, b};
  bf16x2_t r = __builtin_convertvector(v, bf16x2_t);
  return __builtin_bit_cast(uint32_t, r);
}
__device__ __forceinline__ float gelu_tanh(float x) {
  float u = 0.7978845608028654f * (x + 0.044715f * x * x * x);
  float e = __expf(2.f * u);
  float th = 1.f - 2.f / (e + 1.f);
  return 0.5f * x * (1.f + th);
}
__device__ __forceinline__ float wave_sum(float v) {
#pragma unroll
  for (int o = 32; o; o >>= 1) v += __shfl_xor(v, o);
  return v;
}
__device__ __forceinline__ float wave_max(float v) {
#pragma unroll
  for (int o = 32; o; o >>= 1) v = fmaxf(v, __shfl_xor(v, o));
  return v;
}
__device__ __forceinline__ void store_bf4(u16* dst, float a, float b, float c, float d) {
  uint2 w; w.x = pack2(a, b); w.y = pack2(c, d);
  *(uint2*)dst = w;
}

__device__ __forceinline__ void mma_128x128x64(const u16* sA, const u16* sB, f32x4 (&acc)[4][4], int wr, int wc, int fr, int fq) {
  bf16x8 af[2][4], bfr[2][4];
#pragma unroll
  for (int ks = 0; ks < 2; ks++) {
#pragma unroll
    for (int mt = 0; mt < 4; mt++) {
      int row = wr * 64 + mt * 16 + fr;
      int ch = (ks * 4 + fq) ^ ((row >> 1) & 7);
      af[ks][mt] = *(const bf16x8*)(sA + row * 64 + ch * 8);
    }
#pragma unroll
    for (int nt = 0; nt < 4; nt++) {
      int row = wc * 64 + nt * 16 + fr;
      int ch = (ks * 4 + fq) ^ ((row >> 1) & 7);
      bfr[ks][nt] = *(const bf16x8*)(sB + row * 64 + ch * 8);
    }
  }
  __builtin_amdgcn_sched_barrier(0);
  __builtin_amdgcn_s_setprio(1);
#pragma unroll
  for (int ks = 0; ks < 2; ks++)
#pragma unroll
    for (int mt = 0; mt < 4; mt++)
#pragma unroll
      for (int nt = 0; nt < 4; nt++)
        acc[mt][nt] = __builtin_amdgcn_mfma_f32_16x16x32_bf16(bfr[ks][nt], af[ks][mt], acc[mt][nt], 0, 0, 0);
  __builtin_amdgcn_s_setprio(0);
}

template <class BP, class Epi>
__device__ __forceinline__ void gemm_tile(const u16* __restrict__ A, long lda, const int* arow, int m0, BP bptr, int K,
                                          u16* smem, Epi epi) {
  const int t = threadIdx.x, lane = t & 63, wid = t >> 6, wr = wid >> 1, wc = wid & 1, fr = lane & 15, fq = lane >> 4;
  const int lr = t >> 3;
  const int gch = ((t & 7) ^ ((t >> 4) & 7)) << 3;
  const u16 *ap0, *ap1, *ap2, *ap3;
  {
    long g0 = arow ? (long)arow[lr] : (long)(m0 + lr);
    long g1 = arow ? (long)arow[lr + 32] : (long)(m0 + lr + 32);
    long g2 = arow ? (long)arow[lr + 64] : (long)(m0 + lr + 64);
    long g3 = arow ? (long)arow[lr + 96] : (long)(m0 + lr + 96);
    ap0 = A + g0 * lda + gch; ap1 = A + g1 * lda + gch; ap2 = A + g2 * lda + gch; ap3 = A + g3 * lda + gch;
  }
  const u16* bp0 = bptr(lr) + gch;
  const u16* bp1 = bptr(lr + 32) + gch;
  const u16* bp2 = bptr(lr + 64) + gch;
  const u16* bp3 = bptr(lr + 96) + gch;
  f32x4 acc[4][4];
#pragma unroll
  for (int i = 0; i < 4; i++)
#pragma unroll
    for (int j = 0; j < 4; j++) acc[i][j] = f32x4{0.f, 0.f, 0.f, 0.f};
#define GLDS(src, dst) __builtin_amdgcn_global_load_lds((const unsigned*)(src), (unsigned*)(dst), 16, 0, 0)
#define STAGE(k0, buf)                                                          \
  {                                                                             \
    u16* dA = smem + (buf) * 16384 + wid * 512;                                 \
    u16* dB = dA + 8192;                                                        \
    GLDS(ap0 + (k0), dA); GLDS(bp0 + (k0), dB);                                 \
    GLDS(ap1 + (k0), dA + 2048); GLDS(bp1 + (k0), dB + 2048);                   \
    GLDS(ap2 + (k0), dA + 4096); GLDS(bp2 + (k0), dB + 4096);                   \
    GLDS(ap3 + (k0), dA + 6144); GLDS(bp3 + (k0), dB + 6144);                   \
  }
  STAGE(0, 0);
  const int nk = K >> 6;
  for (int kt = 0; kt < nk; kt++) {
    asm volatile("s_waitcnt vmcnt(0)" ::: "memory");
    __syncthreads();
    if (kt + 1 < nk) STAGE((kt + 1) << 6, (kt + 1) & 1);
    const u16* sA = smem + (kt & 1) * 16384;
    mma_128x128x64(sA, sA + 8192, acc, wr, wc, fr, fq);
  }
#undef STAGE
#undef GLDS
#pragma unroll
  for (int mt = 0; mt < 4; mt++) epi(wr * 64 + mt * 16 + fr, wc * 64 + fq * 4, acc[mt]);
}

struct TileDesc { const u16* A; const u16* B; int m0; };
template <class Desc, class Epi>
__device__ __forceinline__ void gemm_stream(int total, long lda, long ldb, int K, u16* smem, Desc desc, Epi epi) {
  const int t = threadIdx.x, lane = t & 63, wid = t >> 6, wr = wid >> 1, wc = wid & 1, fr = lane & 15, fq = lane >> 4;
  const int lr = t >> 3;
  const int gch = ((t & 7) ^ ((t >> 4) & 7)) << 3;
  int j = blockIdx.x;
  if (j >= total) return;
  const u16 *ap, *bp;
  const long as32 = 32 * lda, bs32 = 32 * ldb;
#define SETUP(jj)                                                               \
  {                                                                             \
    TileDesc d_ = desc(jj);                                                     \
    ap = d_.A + (long)(d_.m0 + lr) * lda + gch;                                 \
    bp = d_.B + (long)lr * ldb + gch;                                           \
  }
#define GLDS(src, dst) __builtin_amdgcn_global_load_lds((const unsigned*)(src), (unsigned*)(dst), 16, 0, 0)
#define STAGE(k0, buf)                                                          \
  {                                                                             \
    u16* dA = smem + (buf) * 16384 + wid * 512;                                 \
    u16* dB = dA + 8192;                                                        \
    GLDS(ap + (k0), dA); GLDS(bp + (k0), dB);                                   \
    GLDS(ap + as32 + (k0), dA + 2048); GLDS(bp + bs32 + (k0), dB + 2048);       \
    GLDS(ap + 2 * as32 + (k0), dA + 4096); GLDS(bp + 2 * bs32 + (k0), dB + 4096); \
    GLDS(ap + 3 * as32 + (k0), dA + 6144); GLDS(bp + 3 * bs32 + (k0), dB + 6144); \
  }
  SETUP(j);
  STAGE(0, 0);
  const int nk = K >> 6;
  for (;;) {
    f32x4 acc[4][4];
#pragma unroll
    for (int i = 0; i < 4; i++)
#pragma unroll
      for (int q = 0; q < 4; q++) acc[i][q] = f32x4{0.f, 0.f, 0.f, 0.f};
    for (int kt = 0; kt < nk; kt++) {
      asm volatile("s_waitcnt vmcnt(0)" ::: "memory");
      __syncthreads();
      if (kt + 1 < nk) STAGE((kt + 1) << 6, (kt + 1) & 1);
      const u16* sA = smem + (kt & 1) * 16384;
      mma_128x128x64(sA, sA + 8192, acc, wr, wc, fr, fq);
    }
    const int jn = j + gridDim.x;
    const bool has = jn < total;
    if (has) { SETUP(jn); STAGE(0, 0); }
#pragma unroll
    for (int mt = 0; mt < 4; mt++) epi(j, wr * 64 + mt * 16 + fr, wc * 64 + fq * 4, acc[mt]);
    if (!has) break;
    j = jn;
  }
#undef SETUP
#undef STAGE
#undef GLDS
}

typedef short s16x4 __attribute__((ext_vector_type(4)));
__device__ __forceinline__ int wt_off(int k, int ch) { return 256 * k + 16 * (ch ^ (((k & 3) << 2) | ((k >> 2) & 3))); }

template <class WM, class Epi>
__device__ __forceinline__ void gemm_tile_wf32(const u16* __restrict__ A, long lda, const int* arow, WM wmap, long kstride, int K,
                                               u16* smem, Epi epi) {
  const int t = threadIdx.x, lane = t & 63, wid = t >> 6, wr = wid >> 1, wc = wid & 1, fr = lane & 15, fq = lane >> 4;
  const int lr = t >> 3;
  const int gch = ((t & 7) ^ ((t >> 4) & 7)) << 3;
  const unsigned ao0 = (unsigned)(arow[lr] * (int)lda + gch), ao1 = (unsigned)(arow[lr + 32] * (int)lda + gch);
  const unsigned ao2 = (unsigned)(arow[lr + 64] * (int)lda + gch), ao3 = (unsigned)(arow[lr + 96] * (int)lda + gch);
  const float* wp0;
  int woff0, woff1;
  {
    int kw, vw;
    wmap(kw, vw, wp0);
    woff0 = wt_off(kw, vw >> 3) + ((vw >> 2) & 1) * 8;
    woff1 = wt_off(kw + 8, vw >> 3) + ((vw >> 2) & 1) * 8;
  }
  f32x4 acc[4][4];
#pragma unroll
  for (int i = 0; i < 4; i++)
#pragma unroll
    for (int j = 0; j < 4; j++) acc[i][j] = f32x4{0.f, 0.f, 0.f, 0.f};
  f32x4 wr0[8], wr1[8];
#define GLDS(src, dst) __builtin_amdgcn_global_load_lds((const unsigned*)(src), (unsigned*)(dst), 16, 0, 0)
#define STAGE_A(k0, buf)                                                        \
  {                                                                             \
    u16* dA = smem + (buf) * 16384 + wid * 512;                                 \
    const u16* Ak = A + (k0);                                                   \
    GLDS(Ak + ao0, dA); GLDS(Ak + ao1, dA + 2048);                              \
    GLDS(Ak + ao2, dA + 4096); GLDS(Ak + ao3, dA + 6144);                       \
  }
#define LOAD_W(R, k0)                                                           \
  {                                                                             \
    _Pragma("unroll") for (int i = 0; i < 8; i++) R[i] = *(const f32x4*)(wp0 + (long)((k0) + 8 * i) * kstride); \
  }
#define WRITE_W(R, buf)                                                         \
  {                                                                             \
    char* dB = (char*)(smem + (buf) * 16384 + 8192);                            \
    _Pragma("unroll") for (int i = 0; i < 8; i++) {                             \
      uint2 w2; w2.x = pack2(R[i][0], R[i][1]); w2.y = pack2(R[i][2], R[i][3]); \
      *(uint2*)(dB + ((i & 1) ? woff1 : woff0) + 2048 * (i & ~1)) = w2;                                             \
    }                                                                           \
  }
#define COMPUTE(buf)                                                            \
  {                                                                             \
    const u16* sA = smem + (buf) * 16384;                                       \
    const char* sB = (const char*)(sA + 8192);                                  \
    _Pragma("unroll") for (int ks = 0; ks < 2; ks++) {                          \
      bf16x8 af[4], bfr[4];                                                     \
      _Pragma("unroll") for (int mt = 0; mt < 4; mt++) {                        \
        int row = wr * 64 + mt * 16 + fr;                                       \
        int ch = (ks * 4 + fq) ^ ((row >> 1) & 7);                              \
        af[mt] = *(const bf16x8*)(sA + row * 64 + ch * 8);                      \
      }                                                                         \
      _Pragma("unroll") for (int nt = 0; nt < 4; nt++) {                        \
        const int c0 = (wc * 64 + nt * 16) >> 3;                                \
        const int k0_ = ks * 32 + fq * 8 + tq;                                  \
        s16x4 lo = __builtin_amdgcn_ds_read_tr16_b64_v4i16((s16x4 LAS*)(sB + wt_off(k0_, c0 + (tp >> 1)) + 8 * (tp & 1)));     \
        s16x4 hi = __builtin_amdgcn_ds_read_tr16_b64_v4i16((s16x4 LAS*)(sB + wt_off(k0_ + 4, c0 + (tp >> 1)) + 8 * (tp & 1))); \
        bfr[nt] = bf16x8{lo[0], lo[1], lo[2], lo[3], hi[0], hi[1], hi[2], hi[3]}; \
      }                                                                         \
      _Pragma("unroll") for (int mt = 0; mt < 4; mt++)                          \
        _Pragma("unroll") for (int nt = 0; nt < 4; nt++)                        \
          acc[mt][nt] = __builtin_amdgcn_mfma_f32_16x16x32_bf16(bfr[nt], af[mt], acc[mt][nt], 0, 0, 0); \
    }                                                                           \
  }
  const int tq = fr >> 2, tp = fr & 3;
  const int trb = wt_off(fq * 8 + tq, wc * 8 + (tp >> 1)) + 8 * (tp & 1);
  const int nk = K >> 6;
  STAGE_A(0, 0);
  LOAD_W(wr0, 0);
  LOAD_W(wr1, 64);
  WRITE_W(wr0, 0);
  for (int kt = 0; kt < nk; kt += 2) {
    asm volatile("s_waitcnt vmcnt(8)" ::: "memory");
    __syncthreads();
    STAGE_A((kt + 1) << 6, 1);
    if (kt + 2 < nk) LOAD_W(wr0, (kt + 2) << 6);
    COMPUTE(0);
    WRITE_W(wr1, 1);
    if (kt + 2 < nk) { asm volatile("s_waitcnt vmcnt(8)" ::: "memory"); } else { asm volatile("s_waitcnt vmcnt(0)" ::: "memory"); }
    __syncthreads();
    if (kt + 2 < nk) { STAGE_A((kt + 2) << 6, 0); }
    if (kt + 3 < nk) LOAD_W(wr1, (kt + 3) << 6);
    COMPUTE(1);
    if (kt + 2 < nk) WRITE_W(wr0, 0);
  }
#undef STAGE_A
#undef LOAD_W
#undef WRITE_W
#undef COMPUTE
#undef GLDS
#pragma unroll
  for (int mt = 0; mt < 4; mt++) epi(wr * 64 + mt * 16 + fr, wc * 64 + fq * 4, acc[mt]);
}

__device__ __forceinline__ void transpose_tile(const float* __restrict__ src, u16* __restrict__ dst, int R, int C, int tr, int tc, u16* lds) {
  const int t = threadIdx.x;
#pragma unroll
  for (int i = 0; i < 4; i++) {
    int r = (t >> 4) + 16 * i, c4 = (t & 15) * 4;
    float4 v = *(const float4*)(src + (long)(tr * 64 + r) * C + tc * 64 + c4);
    lds[(c4 + 0) * 66 + r] = f2bf(v.x);
    lds[(c4 + 1) * 66 + r] = f2bf(v.y);
    lds[(c4 + 2) * 66 + r] = f2bf(v.z);
    lds[(c4 + 3) * 66 + r] = f2bf(v.w);
  }
  __syncthreads();
  {
    int n = t >> 2, k0 = (t & 3) * 16;
    const uint32_t* s32 = (const uint32_t*)(lds + n * 66 + k0);
    uint4 a, b;
    a.x = s32[0]; a.y = s32[1]; a.z = s32[2]; a.w = s32[3];
    b.x = s32[4]; b.y = s32[5]; b.z = s32[6]; b.w = s32[7];
    u16* d = dst + (long)(tc * 64 + n) * R + tr * 64 + k0;
    *(uint4*)d = a;
    *(uint4*)(d + 8) = b;
  }
  __syncthreads();
}

__device__ void phase_convert(const Params& p, u16* smem) {
  const int nb = gridDim.x, bid = blockIdx.x, t = threadIdx.x;
  if (bid == 0 && t < NEXP) p.cnt()[t * 32] = 0;
  for (int i = bid * 256 + t; i < 9 * 8 * DM; i += nb * 256) {
    int G = i / (8 * DM), rem = i % (8 * DM), e = rem / DM, d = rem % DM;
    if (G == 0) p.wgT()[e * DM + d] = p.w_group[d * 8 + e];
    else p.wrT()[((G - 1) * 8 + e) * DM + d] = p.w_router[((long)(G - 1) * DM + d) * 8 + e];
  }
  {
    const long n4x = (long)SEQ * DM / 4, n4m = (long)MEML * DM / 4;
    for (long i = (long)bid * 256 + t; i < n4x + n4m; i += (long)nb * 256) {
      const float* s; u16* d; long j;
      if (i < n4x) { s = p.x; d = p.xb(); j = i; } else { s = p.mem; d = p.memb(); j = i - n4x; }
      float4 v = *(const float4*)(s + j * 4);
      store_bf4(d + j * 4, v.x, v.y, v.z, v.w);
    }
  }
  const int T_IN = 2560, T_SQ = 1024;
  const int total = T_IN + 5 * T_SQ;
  for (int j = bid; j < total; j += nb) {
    const float* src; u16* dst; int R, C, tl;
    if (j < T_IN) { src = p.w_in; dst = p.WinT(); R = DM; C = INW; tl = j; }
    else {
      int q = (j - T_IN) / T_SQ; tl = (j - T_IN) % T_SQ; R = DM; C = DM;
      src = q == 0 ? p.w_mix_out : q == 1 ? p.mem_w_q : q == 2 ? p.mem_w_k : q == 3 ? p.mem_w_v : p.mem_w_o;
      dst = q == 0 ? p.WmixT() : q == 1 ? p.WqT() : q == 2 ? p.WkT() : q == 3 ? p.WvT() : p.WoT();
    }
    int ntc = C / 64;
    transpose_tile(src, dst, R, C, tl / ntc, tl % ntc, smem);
  }
}

__device__ void phase_inproj(const Params& p, u16* smem) {
  const int MT = SEQ / 128, NT = INW / 128;
  const u16* xb = p.xb(); const u16* WinT = p.WinT(); u16* proj = p.proj();
  gemm_stream(MT * NT, DM, DM, DM, smem,
              [&](int j) { int mt = j % MT, nt = j / MT; TileDesc d; d.A = xb; d.B = WinT + (long)nt * 128 * DM; d.m0 = mt * 128; return d; },
              [&](int j, int m, int nb, f32x4 (&a)[4]) {
                int mt = j % MT, nt = j / MT;
                int seg = nt >> 3;
                u16* outp = proj + (long)(mt * 128 + m) * INW + nt * 128 + nb;
#pragma unroll
                for (int q = 0; q < 4; q++) {
                  float v0 = a[q][0], v1 = a[q][1], v2 = a[q][2], v3 = a[q][3];
                  if (seg < 2) { v0 = gelu_tanh(v0); v1 = gelu_tanh(v1); v2 = gelu_tanh(v2); v3 = gelu_tanh(v3); }
                  else if (seg == 2) { const float sc = 0.08838834764831845f; v0 *= sc; v1 *= sc; v2 *= sc; v3 *= sc; }
                  store_bf4(outp + q * 16, v0, v1, v2, v3);
                }
              });
}

__device__ void memkv_tile(const Params& p, int jj, u16* smem) {
  int which = jj / 32, r_ = jj % 32, mt = r_ & 1, nt = r_ >> 1;
  const u16* W = (which == 0 ? p.WkT() : p.WvT()) + (long)nt * 128 * DM;
  u16* outk = p.kmem() + (long)mt * 128 * DM + nt * 128;
  u16* outv = p.vmemT() + (long)nt * 128 * MEML + mt * 128;
  gemm_tile(p.memb(), DM, nullptr, mt * 128, [&](int r) { return W + (long)r * DM; }, DM, smem,
            [&](int m, int nb, f32x4 (&a)[4]) {
#pragma unroll
              for (int q = 0; q < 4; q++) {
                if (which == 0) store_bf4(outk + (long)m * DM + nb + q * 16, a[q][0], a[q][1], a[q][2], a[q][3]);
                else {
#pragma unroll
                  for (int e = 0; e < 4; e++) outv[(long)(nb + q * 16 + e) * MEML + m] = f2bf(a[q][e]);
                }
              }
            });
  __syncthreads();
}

__device__ void gmlp_item(const Params& p, int nb, int g, u16* smem) {
  const int t = threadIdx.x, lane = t & 63, wid = t >> 6, wr = wid >> 1, wc = wid & 1, fr = lane & 15, fq = lane >> 4;
  u16* sA = smem;
  u16* sB = smem + 16384;
#pragma unroll
  for (int i = 0; i < 8; i++) {
    int q = t + 256 * i;
    int tt = q >> 4, sc = q & 15, kt = sc >> 3, c = sc & 7;
    const float* src = p.gm_w_s + ((long)g * 128 + tt) * 128 + sc * 8;
    float4 a = *(const float4*)src, b = *(const float4*)(src + 4);
    bool keep = (tt >> 6) >= kt;
    uint4 w;
    w.x = keep ? pack2(a.x, a.y) : 0u; w.y = keep ? pack2(a.z, a.w) : 0u;
    w.z = keep ? pack2(b.x, b.y) : 0u; w.w = keep ? pack2(b.z, b.w) : 0u;
    *(uint4*)(sA + kt * 8192 + tt * 64 + ((c ^ ((tt >> 1) & 7)) << 3)) = w;
  }
  {
    const int s = t >> 1, half = t & 1;
    const u16* vp = p.proj() + (long)(nb * 128 + s) * INW + 1024 + g * 128 + half * 64;
    float v[64];
#pragma unroll
    for (int i = 0; i < 8; i++) {
      uint4 w = *(const uint4*)(vp + i * 8);
      v[i * 8 + 0] = bflo(w.x); v[i * 8 + 1] = bfhi(w.x); v[i * 8 + 2] = bflo(w.y); v[i * 8 + 3] = bfhi(w.y);
      v[i * 8 + 4] = bflo(w.z); v[i * 8 + 5] = bfhi(w.z); v[i * 8 + 6] = bflo(w.w); v[i * 8 + 7] = bfhi(w.w);
    }
    float sum = 0.f;
#pragma unroll
    for (int i = 0; i < 64; i++) sum += v[i];
    sum += __shfl_xor(sum, 1);
    const float mean = sum * (1.f / 128.f);
    float sq = 0.f;
#pragma unroll
    for (int i = 0; i < 64; i++) { float d = v[i] - mean; sq += d * d; }
    sq += __shfl_xor(sq, 1);
    const float rstd = rsqrtf(sq * (1.f / 128.f) + 1e-5f);
    const int kt = s >> 6, kk = s & 63;
    const float* lg = p.gm_ln_g + g * 128 + half * 64;
    const float* lb = p.gm_ln_b + g * 128 + half * 64;
#pragma unroll
    for (int i = 0; i < 64; i++) {
      int cc = half * 64 + i;
      float val = (v[i] - mean) * rstd * lg[i] + lb[i];
      sB[kt * 8192 + cc * 64 + (((kk >> 3) ^ ((cc >> 1) & 7)) << 3) + (kk & 7)] = f2bf(val);
    }
  }
  __syncthreads();
  f32x4 acc[4][4];
#pragma unroll
  for (int i = 0; i < 4; i++)
#pragma unroll
    for (int j = 0; j < 4; j++) acc[i][j] = f32x4{0.f, 0.f, 0.f, 0.f};
  mma_128x128x64(sA, sB, acc, wr, wc, fr, fq);
  mma_128x128x64(sA + 8192, sB + 8192, acc, wr, wc, fr, fq);
#pragma unroll
  for (int mt = 0; mt < 4; mt++) {
    int m = wr * 64 + mt * 16 + fr;
    float bs = p.gm_b_s[g * 128 + m];
    const u16* up = p.proj() + (long)(nb * 128 + m) * INW + g * 128;
    u16* op = p.mixcat() + (long)(nb * 128 + m) * DM + g * 128;
#pragma unroll
    for (int nt = 0; nt < 4; nt++) {
      int n = wc * 64 + nt * 16 + fq * 4;
      uint2 uw = *(const uint2*)(up + n);
      f32x4 a = acc[mt][nt];
      store_bf4(op + n, bflo(uw.x) * (a[0] + bs), bfhi(uw.x) * (a[1] + bs), bflo(uw.y) * (a[2] + bs), bfhi(uw.y) * (a[3] + bs));
    }
  }
  __syncthreads();
}

__device__ void attn_item(const Params& p, int h, int qt, u16* smem) {
  u16* sK = smem;
  u16* sP = smem;
  u16* sVt = smem + 8192;
  float* sS = (float*)(smem + 16384);
  const int t = threadIdx.x, lane = t & 63, w = t >> 6, fr = lane & 15, fq = lane >> 4;
  const int q0 = qt * 128;
  const u16* Qb = p.proj() + 2048 + h * 128;
  const u16* Kb = p.proj() + 3072 + h * 128;
  const u16* Vb = p.proj() + 4096 + h * 128;
  f32x4 o[2][8];
#pragma unroll
  for (int i = 0; i < 2; i++)
#pragma unroll
    for (int j = 0; j < 8; j++) o[i][j] = f32x4{0.f, 0.f, 0.f, 0.f};
  const int srow = t >> 1, half = t & 1;
  const int qg = q0 + srow;
  float crow = 0.f;
  for (int kb = qt * 2 + 1; kb >= 0; kb--) {
    bf16x8 qf[2][4];
#pragma unroll
    for (int mt = 0; mt < 2; mt++)
#pragma unroll
      for (int ks = 0; ks < 4; ks++)
        qf[mt][ks] = *(const bf16x8*)(Qb + (long)(q0 + w * 32 + mt * 16 + fr) * INW + ks * 32 + fq * 8);
#pragma unroll
    for (int i = 0; i < 4; i++) {
      int idx = t + 256 * i;
      int key = idx >> 4, ch = idx & 15;
      uint4 kv = *(const uint4*)(Kb + (long)(kb * 64 + key) * INW + ch * 8);
      *(uint4*)(sK + key * 128 + ((ch ^ (key & 15)) << 3)) = kv;
      uint4 vv = *(const uint4*)(Vb + (long)(kb * 64 + key) * INW + ch * 8);
      *(uint4*)((char*)sVt + wt_off(key, ch)) = vv;
    }
    __syncthreads();
#pragma unroll
    for (int nt = 0; nt < 4; nt++) {
      f32x4 s0 = f32x4{0.f, 0.f, 0.f, 0.f}, s1 = f32x4{0.f, 0.f, 0.f, 0.f};
      const int krow = nt * 16 + fr;
#pragma unroll
      for (int ks = 0; ks < 4; ks++) {
        bf16x8 kf = *(const bf16x8*)(sK + krow * 128 + (((ks * 4 + fq) ^ (krow & 15)) << 3));
        s0 = __builtin_amdgcn_mfma_f32_16x16x32_bf16(kf, qf[0][ks], s0, 0, 0, 0);
        s1 = __builtin_amdgcn_mfma_f32_16x16x32_bf16(kf, qf[1][ks], s1, 0, 0, 0);
      }
      *(f32x4*)(sS + (w * 32 + fr) * 68 + nt * 16 + fq * 4) = s0;
      *(f32x4*)(sS + (w * 32 + 16 + fr) * 68 + nt * 16 + fq * 4) = s1;
    }
    __syncthreads();
    {
      float z[32];
      float* srp = sS + srow * 68 + half * 32;
#pragma unroll
      for (int j4 = 0; j4 < 8; j4++) {
        f32x4 v = *(const f32x4*)(srp + j4 * 4);
        z[j4 * 4 + 0] = v[0]; z[j4 * 4 + 1] = v[1]; z[j4 * 4 + 2] = v[2]; z[j4 * 4 + 3] = v[3];
      }
      const int kbase = kb * 64 + half * 32;
      float tot = 0.f;
#pragma unroll
      for (int j4 = 0; j4 < 8; j4++) {
        f32x4 sv;
#pragma unroll
        for (int e = 0; e < 4; e++) {
          const int j = j4 * 4 + e;
          bool valid = (kbase + j) < qg;
          float zz = z[j];
          float s = valid ? (fmaxf(zz, 0.f) + __logf(1.f + __expf(-fabsf(zz)))) : 0.f;
          sv[e] = s;
          tot += s;
          z[j] = zz - s;
        }
        *(f32x4*)(srp + j4 * 4) = sv;
      }
      const float ptot = __shfl_xor(tot, 1);
      float c = crow + (half == 0 ? ptot : 0.f);
#pragma unroll
      for (int j4 = 7; j4 >= 0; j4--) {
        f32x4 sv = *(const f32x4*)(srp + j4 * 4);
#pragma unroll
        for (int e = 3; e >= 0; e--) {
          const int j = j4 * 4 + e;
          bool valid = (kbase + j) < qg;
          float a = valid ? __expf(z[j] - c) : 0.f;
          c += sv[e];
          z[j] = a;
        }
      }
      crow += tot + ptot;
#pragma unroll
      for (int q = 0; q < 4; q++) {
        uint4 wv;
        wv.x = pack2(z[q * 8 + 0], z[q * 8 + 1]); wv.y = pack2(z[q * 8 + 2], z[q * 8 + 3]);
        wv.z = pack2(z[q * 8 + 4], z[q * 8 + 5]); wv.w = pack2(z[q * 8 + 6], z[q * 8 + 7]);
        *(uint4*)(sP + srow * 64 + (((half * 4 + q) ^ ((srow >> 1) & 7)) << 3)) = wv;
      }
    }
    const int done = __syncthreads_and(crow > SB_THRESH);
#pragma unroll
    for (int ks = 0; ks < 2; ks++) {
      bf16x8 pf[2];
#pragma unroll
      for (int mt = 0; mt < 2; mt++) {
        int row = w * 32 + mt * 16 + fr;
        pf[mt] = *(const bf16x8*)(sP + row * 64 + (((ks * 4 + fq) ^ ((row >> 1) & 7)) << 3));
      }
#pragma unroll
      for (int nt = 0; nt < 8; nt++) {
        const int vk0 = ks * 32 + fq * 8 + (fr >> 2), vc = nt * 2 + ((fr & 3) >> 1), vb8 = 8 * (fr & 1);
        s16x4 vlo = __builtin_amdgcn_ds_read_tr16_b64_v4i16((s16x4 LAS*)((const char*)sVt + wt_off(vk0, vc) + vb8));
        s16x4 vhi = __builtin_amdgcn_ds_read_tr16_b64_v4i16((s16x4 LAS*)((const char*)sVt + wt_off(vk0 + 4, vc) + vb8));
        bf16x8 vf = bf16x8{vlo[0], vlo[1], vlo[2], vlo[3], vhi[0], vhi[1], vhi[2], vhi[3]};
        o[0][nt] = __builtin_amdgcn_mfma_f32_16x16x32_bf16(vf, pf[0], o[0][nt], 0, 0, 0);
        o[1][nt] = __builtin_amdgcn_mfma_f32_16x16x32_bf16(vf, pf[1], o[1][nt], 0, 0, 0);
      }
    }
    __syncthreads();
    if (done) break;
  }
#pragma unroll
  for (int mt = 0; mt < 2; mt++) {
    u16* op = p.mixcat() + (long)(q0 + w * 32 + mt * 16 + fr) * DM + 1024 + h * 128;
#pragma unroll
    for (int nt = 0; nt < 8; nt++) {
      f32x4 a = o[mt][nt];
      store_bf4(op + nt * 16 + fq * 4, a[0], a[1], a[2], a[3]);
    }
  }
}

__device__ void phase_mix(const Params& p, u16* smem) {
  const int NA = 8 * 64, NG = 64 * 8;
#ifndef NO_ATTN
  for (int j = blockIdx.x; j < NA; j += gridDim.x) { int qt = 63 - (j >> 3), h = j & 7; attn_item(p, h, qt, smem); }
#endif
#ifndef NO_GMLP
  for (int j = blockIdx.x; j < NG; j += gridDim.x) gmlp_item(p, j >> 3, j & 7, smem);
#endif
  for (int j = gridDim.x - 1 - blockIdx.x; j < 64; j += gridDim.x) memkv_tile(p, j, smem);
}

template <bool RES_BF16>
__device__ __forceinline__ void gemm_residual(const u16* A, const u16* WT, const void* res_, float* pre, u16* smem) {
  const int MT = SEQ / 128, NT = DM / 128;
  gemm_stream(MT * NT, DM, DM, DM, smem,
              [&](int j) { int mt = j % MT, nt = j / MT; TileDesc d; d.A = A; d.B = WT + (long)nt * 128 * DM; d.m0 = mt * 128; return d; },
              [&](int j, int m, int nb, f32x4 (&a)[4]) {
                int mt = j % MT, nt = j / MT;
                const long off = (long)(mt * 128 + m) * DM + nt * 128 + nb;
#pragma unroll
                for (int q = 0; q < 4; q++) {
                  float4 xv;
                  if (RES_BF16) {
                    uint2 xw = *(const uint2*)((const u16*)res_ + off + q * 16);
                    xv.x = bflo(xw.x); xv.y = bfhi(xw.x); xv.z = bflo(xw.y); xv.w = bfhi(xw.y);
                  } else {
                    xv = *(const float4*)((const float*)res_ + off + q * 16);
                  }
                  float4 r; r.x = DN_ALPHA * xv.x + a[q][0]; r.y = DN_ALPHA * xv.y + a[q][1]; r.z = DN_ALPHA * xv.z + a[q][2]; r.w = DN_ALPHA * xv.w + a[q][3];
                  *(float4*)(pre + off + q * 16) = r;
                }
              });
}
__device__ void phase_mixout(const Params& p, u16* smem) { gemm_residual<false>(p.mixcat(), p.WmixT(), p.x, p.pre(), smem); }
__device__ void phase_oproj(const Params& p, u16* smem) { gemm_residual<true>(p.om(), p.WoT(), p.hb(), p.pre(), smem); }

__device__ void phase_qproj(const Params& p, u16* smem) {
  const int MT = SEQ / 128, NT = DM / 128;
  const u16* hb = p.hb(); const u16* WqT = p.WqT(); u16* qm = p.qm();
  gemm_stream(MT * NT, DM, DM, DM, smem,
              [&](int j) { int mt = j % MT, nt = j / MT; TileDesc d; d.A = hb; d.B = WqT + (long)nt * 128 * DM; d.m0 = mt * 128; return d; },
              [&](int j, int m, int nb, f32x4 (&a)[4]) {
                int mt = j % MT, nt = j / MT;
                u16* outp = qm + (long)(mt * 128 + m) * DM + nt * 128 + nb;
                const float sc = 0.04419417382415922f;
#pragma unroll
                for (int q = 0; q < 4; q++) store_bf4(outp + q * 16, a[q][0] * sc, a[q][1] * sc, a[q][2] * sc, a[q][3] * sc);
              });
}

__device__ void phase_scores(const Params& p, u16* smem) {
  const int MT = SEQ / 128;
  const u16* qm = p.qm(); const u16* kmem = p.kmem(); float* scores = p.scores();
  gemm_stream(4 * MT * 2, DM, DM, 512, smem,
              [&](int j) { int mt = j % MT, r_ = j / MT, nt = r_ & 1, h = r_ >> 1; TileDesc d; d.A = qm + h * 512; d.B = kmem + (long)nt * 128 * DM + h * 512; d.m0 = mt * 128; return d; },
              [&](int j, int m, int nb, f32x4 (&a)[4]) {
                int mt = j % MT, r_ = j / MT, nt = r_ & 1, h = r_ >> 1;
                float* outp = scores + ((long)h * SEQ + mt * 128 + m) * MEML + nt * 128 + nb;
#pragma unroll
                for (int q = 0; q < 4; q++) {
                  float4 r4; r4.x = a[q][0]; r4.y = a[q][1]; r4.z = a[q][2]; r4.w = a[q][3];
                  *(float4*)(outp + q * 16) = r4;
                }
              });
}

__device__ void phase_softmax(const Params& p) {
  const int wpb = 4, lane = threadIdx.x & 63, wid = threadIdx.x >> 6;
  const int nrows = 4 * SEQ;
  for (int r = blockIdx.x * wpb + wid; r < nrows; r += gridDim.x * wpb) {
    float4 v = *(const float4*)(p.scores() + (long)r * MEML + lane * 4);
    float mx = wave_max(fmaxf(fmaxf(v.x, v.y), fmaxf(v.z, v.w)));
    float e0 = __expf(v.x - mx), e1 = __expf(v.y - mx), e2 = __expf(v.z - mx), e3 = __expf(v.w - mx);
    float inv = 1.f / wave_sum(e0 + e1 + e2 + e3);
    store_bf4(p.Pm() + (long)r * MEML + lane * 4, e0 * inv, e1 * inv, e2 * inv, e3 * inv);
  }
}

__device__ void phase_pv(const Params& p, u16* smem) {
  const int MT = SEQ / 128;
  const u16* Pm = p.Pm(); const u16* vmemT = p.vmemT(); u16* om = p.om();
  gemm_stream(4 * MT * 4, MEML, MEML, MEML, smem,
              [&](int j) { int mt = j % MT, r_ = j / MT, nt = r_ & 3, h = r_ >> 2; TileDesc d; d.A = Pm + (long)h * SEQ * MEML; d.B = vmemT + (long)(h * 512 + nt * 128) * MEML; d.m0 = mt * 128; return d; },
              [&](int j, int m, int nb, f32x4 (&a)[4]) {
                int mt = j % MT, r_ = j / MT, nt = r_ & 3, h = r_ >> 2;
                u16* outp = om + (long)(mt * 128 + m) * DM + h * 512 + nt * 128 + nb;
#pragma unroll
                for (int q = 0; q < 4; q++) store_bf4(outp + q * 16, a[q][0], a[q][1], a[q][2], a[q][3]);
              });
}

__device__ __forceinline__ void ln_stats(const float (&v)[32], float& mean, float& rstd) {
  float s = 0.f;
#pragma unroll
  for (int i = 0; i < 32; i++) s += v[i];
  mean = wave_sum(s) * (1.f / DM);
  float q = 0.f;
#pragma unroll
  for (int i = 0; i < 32; i++) { float d = v[i] - mean; q += d * d; }
  rstd = rsqrtf(wave_sum(q) * (1.f / DM) + 1e-5f);
}

typedef const f32x4 __attribute__((address_space(1)))* g_cv4;
typedef f32x4 __attribute__((address_space(1)))* g_v4;
typedef unsigned int u32x2 __attribute__((ext_vector_type(2)));
typedef const u32x2 __attribute__((address_space(1)))* g_cu2;
typedef u32x2 __attribute__((address_space(1)))* g_u2;
template <class G, class T> __device__ __forceinline__ G opaque_g(T* q) { asm volatile("" : "+v"(q)); return (G)q; }

template <int MODE>
__device__ void phase_ln(const Params& p, u16* smem) {
  const int lane = threadIdx.x & 63, wid = threadIdx.x >> 6;
  const float* gam = MODE == 0 ? p.ln1_g : p.ln3_g;
  const float* bet = MODE == 0 ? p.ln1_b : p.ln3_b;
  for (int rb = (blockIdx.x * 4 + wid) * 2; rb < SEQ; rb += gridDim.x * 8) {
    float v[2][32];
#pragma unroll
    for (int q = 0; q < 2; q++) {
      const int r = rb + q;
      if (MODE == 0) {
        g_cv4 pr = opaque_g<g_cv4>(p.pre() + (long)r * DM + lane * 4);
#pragma unroll
        for (int i = 0; i < 8; i++) {
          f32x4 a = pr[i * 64];
          v[q][i * 4 + 0] = a[0]; v[q][i * 4 + 1] = a[1]; v[q][i * 4 + 2] = a[2]; v[q][i * 4 + 3] = a[3];
        }
      } else {
        g_cu2 ph = opaque_g<g_cu2>(p.hb() + (long)r * DM + lane * 4);
        g_cu2 py0 = opaque_g<g_cu2>(p.yslot() + (long)(2 * r) * DM + lane * 4);
        g_cu2 py1 = opaque_g<g_cu2>(p.yslot() + (long)(2 * r + 1) * DM + lane * 4);
#pragma unroll
        for (int i = 0; i < 8; i++) {
          u32x2 hw = ph[i * 64], y0 = py0[i * 64], y1 = py1[i * 64];
          v[q][i * 4 + 0] = DN_ALPHA * bflo(hw[0]) + (bflo(y0[0]) + bflo(y1[0]));
          v[q][i * 4 + 1] = DN_ALPHA * bfhi(hw[0]) + (bfhi(y0[0]) + bfhi(y1[0]));
          v[q][i * 4 + 2] = DN_ALPHA * bflo(hw[1]) + (bflo(y0[1]) + bflo(y1[1]));
          v[q][i * 4 + 3] = DN_ALPHA * bfhi(hw[1]) + (bfhi(y0[1]) + bfhi(y1[1]));
        }
      }
    }
    float mean[2], rstd[2];
    ln_stats(v[0], mean[0], rstd[0]);
    ln_stats(v[1], mean[1], rstd[1]);
    g_cv4 pg = opaque_g<g_cv4>(gam + lane * 4);
    g_cv4 pb = opaque_g<g_cv4>(bet + lane * 4);
#pragma unroll
    for (int q = 0; q < 2; q++) {
      g_v4 po = opaque_g<g_v4>(p.out + (long)(rb + q) * DM + lane * 4);
      g_u2 ph = opaque_g<g_u2>(p.hb() + (long)(rb + q) * DM + lane * 4);
#pragma unroll
      for (int i = 0; i < 8; i++) {
        f32x4 g = pg[i * 64], b = pb[i * 64];
        f32x4 o4;
#pragma unroll
        for (int e = 0; e < 4; e++) o4[e] = (v[q][i * 4 + e] - mean[q]) * rstd[q] * g[e] + b[e];
        if (MODE == 2) po[i * 64] = o4;
        else { u32x2 w = {pack2(o4[0], o4[1]), pack2(o4[2], o4[3])}; ph[i * 64] = w; }
      }
    }
  }
}

typedef const f32x4 __attribute__((address_space(1)))* gv4p;
__device__ __forceinline__ gv4p launder_g(const float* q) { asm volatile("" : "+v"(q)); return (gv4p)q; }

__device__ __forceinline__ void wave_reduce8(float (&a)[8], int lane) {
  float b[4], c[2], d;
  const bool h5 = lane & 32, h4 = lane & 16, h3 = lane & 8;
#pragma unroll
  for (int k = 0; k < 4; k++) {
    float send = h5 ? a[k] : a[k + 4];
    float keep = h5 ? a[k + 4] : a[k];
    b[k] = keep + __shfl_xor(send, 32);
  }
#pragma unroll
  for (int k = 0; k < 2; k++) {
    float send = h4 ? b[k] : b[k + 2];
    float keep = h4 ? b[k + 2] : b[k];
    c[k] = keep + __shfl_xor(send, 16);
  }
  {
    float send = h3 ? c[0] : c[1];
    float keep = h3 ? c[1] : c[0];
    d = keep + __shfl_xor(send, 8);
  }
  d += __shfl_xor(d, 4);
  d += __shfl_xor(d, 2);
  d += __shfl_xor(d, 1);
#pragma unroll
  for (int g = 0; g < 8; g++) a[g] = __shfl(d, ((g >> 2) & 1) * 32 + ((g >> 1) & 1) * 16 + (g & 1) * 8);
}

__device__ void phase_ln2_route(const Params& p) {
  const int lane = threadIdx.x & 63, wid = threadIdx.x >> 6;
  const float* wgT = p.wgT();
  const float* wrT = p.wrT();
#define CH(i) ((i) * 256)
  for (int rb = (blockIdx.x * 4 + wid) * 2; rb < SEQ; rb += gridDim.x * 8) {
    float v[2][32];
#pragma unroll
    for (int q = 0; q < 2; q++)
#pragma unroll
      for (int i = 0; i < 8; i++) {
        f32x4 a = *(const f32x4*)(p.pre() + (long)(rb + q) * DM + CH(i) + lane * 4);
        v[q][i * 4 + 0] = a[0]; v[q][i * 4 + 1] = a[1]; v[q][i * 4 + 2] = a[2]; v[q][i * 4 + 3] = a[3];
      }
    float mean[2], rstd[2];
    ln_stats(v[0], mean[0], rstd[0]);
    ln_stats(v[1], mean[1], rstd[1]);
#pragma unroll
    for (int i = 0; i < 8; i++) {
      int c = CH(i) + lane * 4;
      f32x4 g = *(const f32x4*)(p.ln2_g + c), b = *(const f32x4*)(p.ln2_b + c);
#pragma unroll
      for (int q = 0; q < 2; q++) {
        f32x4 o4;
#pragma unroll
        for (int e = 0; e < 4; e++) { o4[e] = (v[q][i * 4 + e] - mean[q]) * rstd[q] * g[e] + b[e]; v[q][i * 4 + e] = o4[e]; }
        store_bf4(p.hb() + (long)(rb + q) * DM + c, o4[0], o4[1], o4[2], o4[3]);
      }
    }
    float lg[2][8];
    {
      f32x4 wb[2][8];
      {
        gv4p wp = launder_g(wgT + lane * 4);
#pragma unroll
        for (int i = 0; i < 8; i++) wb[0][i] = wp[CH(i) >> 2];
      }
#pragma unroll
      for (int g = 0; g < 8; g++) {
        if (g + 1 < 8) {
          gv4p wp = launder_g(wgT + (g + 1) * DM + lane * 4);
#pragma unroll
          for (int i = 0; i < 8; i++) wb[(g + 1) & 1][i] = wp[CH(i) >> 2];
        }
        __builtin_amdgcn_sched_barrier(0);
        float s0 = 0.f, s1 = 0.f;
#pragma unroll
        for (int i = 0; i < 8; i++)
#pragma unroll
          for (int e = 0; e < 4; e++) { s0 += wb[g & 1][i][e] * v[0][i * 4 + e]; s1 += wb[g & 1][i][e] * v[1][i * 4 + e]; }
        lg[0][g] = s0; lg[1][g] = s1;
        __builtin_amdgcn_sched_barrier(0);
      }
    }
    wave_reduce8(lg[0], lane);
    wave_reduce8(lg[1], lane);
    int gi[2]; float gval[2];
#pragma unroll
    for (int q = 0; q < 2; q++) {
#pragma unroll
      for (int g = 0; g < 8; g++) lg[q][g] += p.b_group[g];
      int bi = 0; float gm = lg[q][0];
#pragma unroll
      for (int g = 1; g < 8; g++) if (lg[q][g] > gm) { gm = lg[q][g]; bi = g; }
      float gs = 0.f;
#pragma unroll
      for (int g = 0; g < 8; g++) gs += __expf(lg[q][g] - gm);
      gval[q] = 1.f / gs;
      gi[q] = __builtin_amdgcn_readfirstlane(bi);
    }
    float le[2][8];
    {
      const float* wr0_ = wrT + (long)gi[0] * 8 * DM;
      const float* wr1_ = wrT + (long)gi[1] * 8 * DM;
      f32x4 wb[2][8];
      {
        gv4p wp = launder_g(wr0_ + lane * 4);
#pragma unroll
        for (int i = 0; i < 8; i++) wb[0][i] = wp[CH(i) >> 2];
      }
#pragma unroll
      for (int u = 0; u < 16; u++) {
        if (u + 1 < 16) {
          gv4p wp = launder_g((((u + 1) >> 3) ? wr1_ : wr0_) + ((u + 1) & 7) * DM + lane * 4);
#pragma unroll
          for (int i = 0; i < 8; i++) wb[(u + 1) & 1][i] = wp[CH(i) >> 2];
        }
        __builtin_amdgcn_sched_barrier(0);
        float s0 = 0.f;
#pragma unroll
        for (int i = 0; i < 8; i++)
#pragma unroll
          for (int e = 0; e < 4; e++) s0 += wb[u & 1][i][e] * v[u >> 3][i * 4 + e];
        le[u >> 3][u & 7] = s0;
        __builtin_amdgcn_sched_barrier(0);
      }
    }
    wave_reduce8(le[0], lane);
    wave_reduce8(le[1], lane);
#pragma unroll
    for (int q = 0; q < 2; q++) {
#pragma unroll
      for (int g = 0; g < 8; g++) le[q][g] += p.b_router[gi[q] * 8 + g];
      int i1 = 0; float v1 = le[q][0];
#pragma unroll
      for (int g = 1; g < 8; g++) if (le[q][g] > v1) { v1 = le[q][g]; i1 = g; }
      int i2 = 0; float v2 = -3.0e38f;
#pragma unroll
      for (int g = 0; g < 8; g++) if (g != i1 && le[q][g] > v2) { v2 = le[q][g]; i2 = g; }
      float e2 = __expf(v2 - v1);
      float g1 = gval[q] / (1.f + e2), g2 = gval[q] * e2 / (1.f + e2);
      if (lane == 0) {
        const int r = rb + q;
        int ea = gi[q] * 8 + i1, eb = gi[q] * 8 + i2;
        int pa = atomicAdd(&p.cnt()[ea * 32], 1);
        p.rowlist()[ea * SEQ + pa] = 2 * r;
        p.gates()[2 * r] = g1;
        int pb = atomicAdd(&p.cnt()[eb * 32], 1);
        p.rowlist()[eb * SEQ + pb] = 2 * r + 1;
        p.gates()[2 * r + 1] = g2;
      }
    }
  }
}
#undef CH

template <int STAGE>
__device__ void phase_moe(const Params& p, u16* smem) {
  int* sInfo = (int*)(smem + 32768);
  int* sPref = sInfo;
  int* sArow = sInfo + 128;
  int* sAsg = sInfo + 256;
  const int t = threadIdx.x;
  const int xg = (gridDim.x >= 8) ? (int)(blockIdx.x & 7) : 0;
  const int ngrp = (gridDim.x >= 8) ? 8 : 1;
  const int lb = (gridDim.x >= 8) ? (int)(blockIdx.x >> 3) : (int)blockIdx.x;
  const int nlb = (gridDim.x >= 8) ? (int)((gridDim.x - xg + 7) >> 3) : (int)gridDim.x;
  const int nex = NEXP / ngrp;
  if (t == 0) {
    int acc = 0;
    for (int q = 0; q < nex; q++) { sPref[q] = acc; acc += (p.cnt()[(xg + ngrp * q) * 32] + 127) >> 7; }
    sPref[nex] = acc;
  }
  __syncthreads();
  const int NT = STAGE == 0 ? (DEXP / 64) : (DM / 128);
  const int total = sPref[nex] * NT;
  for (int j = lb; j < total; j += nlb) {
    int nt = j % NT, mg = j / NT;
    int eq = 0;
    for (int q = 0; q < nex; q++) if (sPref[q + 1] <= mg) eq = q + 1;
    int mt = mg - sPref[eq];
    const int e = xg + ngrp * eq;
    int ce = p.cnt()[e * 32];
    if (t < 128) {
      int idx = mt * 128 + t;
      int a = idx < ce ? p.rowlist()[e * SEQ + idx] : -1;
      sAsg[t] = a;
      sArow[t] = a < 0 ? 0 : (STAGE == 0 ? (a >> 1) : a);
    }
    __syncthreads();
    if (STAGE == 0) {
      const float* W1 = p.w1 + (long)e * DM * DEXP + nt * 64;
      const float* W3 = p.w3 + (long)e * DM * DEXP + nt * 64;
      u16* hidp = p.hid() + nt * 64;
      gemm_tile_wf32(p.hb(), DM, sArow,
                [&](int& k, int& v, const float*& src) {
                  int which = (t >> 4) & 1;
                  k = t >> 5;
                  int c4 = (t & 15) * 4;
                  v = (c4 >> 4) * 32 + which * 16 + (c4 & 15);
                  src = (which ? W3 : W1) + (long)k * DEXP + c4;
                }, DEXP, DM, smem,
                [&](int m, int nb, f32x4 (&a)[4]) {
                  int as = sAsg[m];
                  if (as >= 0) {
                    int wc = nb >> 6, f4 = nb & 63;
#pragma unroll
                    for (int q = 0; q < 2; q++) {
                      f32x4 g = a[2 * q], u = a[2 * q + 1];
                      float r0 = g[0] / (1.f + __expf(-g[0])) * u[0];
                      float r1 = g[1] / (1.f + __expf(-g[1])) * u[1];
                      float r2 = g[2] / (1.f + __expf(-g[2])) * u[2];
                      float r3 = g[3] / (1.f + __expf(-g[3])) * u[3];
                      store_bf4(hidp + (long)as * DEXP + (wc * 2 + q) * 16 + f4, r0, r1, r2, r3);
                    }
                  }
                });
    } else {
      const float* W2 = p.w2 + (long)e * DEXP * DM + nt * 128;
      u16* yp = p.yslot() + nt * 128;
      const float* gp = p.gates();
      gemm_tile_wf32(p.hid(), DEXP, sArow,
                [&](int& k, int& v, const float*& src) {
                  k = t >> 5;
                  v = (t & 31) * 4;
                  src = W2 + (long)k * DM + v;
                }, DM, DEXP, smem,
                [&](int m, int nb, f32x4 (&a)[4]) {
                  int as = sAsg[m];
                  if (as >= 0) {
                    float gt = gp[as];
#pragma unroll
                    for (int q = 0; q < 4; q++) store_bf4(yp + (long)as * DM + nb + q * 16, gt * a[q][0], gt * a[q][1], gt * a[q][2], gt * a[q][3]);
                  }
                });
    }
    __syncthreads();
  }
}


#define XB_TMO      128
#define XB_XCNT(j)  (256  + 64 * (j))
#define XB_XSUB(j)  (1280 + 64 * (j))
#define XB_XGEN(j)  (2304 + 64 * (j))
#define XB_TOP      3328
#define XB_TOPGEN   3392
#define XCD_BAR_WORDS 3456
#define XB_SPIN_CAP (1u << 22)
__device__ __forceinline__ unsigned xb_ld(unsigned* p) { return __hip_atomic_load(p, __ATOMIC_RELAXED, __HIP_MEMORY_SCOPE_AGENT); }
__device__ __forceinline__ unsigned xb_add(unsigned* p, unsigned v) { return __hip_atomic_fetch_add(p, v, __ATOMIC_RELAXED, __HIP_MEMORY_SCOPE_AGENT); }
__device__ __forceinline__ unsigned xb_xcc_id() { return (unsigned)__builtin_amdgcn_s_getreg((3 << 11) | 20) & 0xFu; }
#define XB_SPIN(cond, bar) do { unsigned _sp = 0; while (cond) { __builtin_amdgcn_s_sleep(1); \
    if ((++_sp & 255u) == 0u) { if (xb_ld(&(bar)[XB_TMO])) break; if (_sp > XB_SPIN_CAP) { atomicAdd(&(bar)[XB_TMO], 1u); break; } } } } while (0)
struct XcdBarrier { unsigned* bar; unsigned x; volatile LAS unsigned* st; };
__device__ __forceinline__ XcdBarrier xcd_barrier_post(unsigned* bar, volatile LAS unsigned* st) {
  XcdBarrier b; b.bar = bar; b.x = xb_xcc_id(); b.st = st;
  if (threadIdx.x == 0) (void)xb_add(&bar[XB_XCNT(b.x)], 1u);
  return b;
}
__device__ __forceinline__ void xcd_barrier_complete(unsigned* bar, unsigned x, unsigned& nloc, unsigned& nx) {
  const unsigned G = gridDim.x;
  unsigned sum, cnt, mine, sp = 0u;
  for (;;) {
    sum = 0u; cnt = 0u; mine = 0u;
#pragma unroll
    for (unsigned j = 0; j < 16; ++j) { const unsigned c = xb_ld(&bar[XB_XCNT(j)]); sum += c; cnt += (c > 0u) ? 1u : 0u; mine = (j == x) ? c : mine; }
    if (sum == G) break;
    __builtin_amdgcn_s_sleep(1);
    if ((++sp & 255u) == 0u) { if (xb_ld(&bar[XB_TMO])) break; if (sp > XB_SPIN_CAP) { atomicAdd(&bar[XB_TMO], 1u); break; } }
  }
  nloc = mine > 0u ? mine : 1u; nx = cnt > 0u ? cnt : 1u;
}
__device__ __forceinline__ void xcd_barrier(const XcdBarrier& b) {
  asm volatile("s_waitcnt vmcnt(0)" ::: "memory");
  __syncthreads();
  if (threadIdx.x == 0) {
    unsigned* bar = b.bar;
    __builtin_amdgcn_s_waitcnt(0);
    unsigned nloc = b.st[0], nx = b.st[1];
    if (nloc == 0u) { xcd_barrier_complete(bar, b.x, nloc, nx); b.st[0] = nloc; b.st[1] = nx; }
    const unsigned old = xb_add(&bar[XB_XSUB(b.x)], 1u);
    const unsigned gen = old / nloc;
    if (old + 1u == (gen + 1u) * nloc) {
      __builtin_amdgcn_fence(__ATOMIC_RELEASE, "agent");
      asm volatile("s_waitcnt vmcnt(0)" ::: "memory");
      const unsigned og = xb_add(&bar[XB_TOP], 1u);
      const unsigned tg = og / nx;
      if (og + 1u == (tg + 1u) * nx) xb_add(&bar[XB_TOPGEN], 1u);
      else XB_SPIN(xb_ld(&bar[XB_TOPGEN]) == tg, bar);
      __builtin_amdgcn_fence(__ATOMIC_ACQUIRE, "agent");
      xb_add(&bar[XB_XGEN(b.x)], 1u);
      asm volatile("s_waitcnt vmcnt(0)" ::: "memory");
    } else {
      XB_SPIN(xb_ld(&bar[XB_XGEN(b.x)]) == gen, bar);
      __builtin_amdgcn_fence(__ATOMIC_ACQUIRE, "agent");
      asm volatile("s_waitcnt vmcnt(0)" ::: "memory");
    }
  }
  __syncthreads();
}

constexpr int NPH = 14;
__device__ __forceinline__ void run_phase(const Params& p, int ph, u16* smem) {
  switch (ph) {
    case 0: phase_convert(p, smem); break;
    case 1: phase_inproj(p, smem); break;
    case 2: phase_mix(p, smem); break;
    case 3: phase_mixout(p, smem); break;
    case 4: phase_ln<0>(p, smem); break;
    case 5: phase_qproj(p, smem); break;
    case 6: phase_scores(p, smem); break;
    case 7: phase_softmax(p); break;
    case 8: phase_pv(p, smem); break;
    case 9: phase_oproj(p, smem); break;
    case 10: phase_ln2_route(p); break;
    case 11: phase_moe<0>(p, smem); break;
    case 12: phase_moe<1>(p, smem); break;
    case 13: phase_ln<2>(p, smem); break;
  }
}

__global__ void __launch_bounds__(256, 2) mega_kernel(Params p) {
  extern __shared__ __attribute__((aligned(16))) u16 smem[];
  __shared__ uint4 xb_words;
  cg::grid_group grid = cg::this_grid();
  if (threadIdx.x == 0) xb_words = make_uint4(0u, 0u, 0u, 0u);
  __syncthreads();
  const XcdBarrier xb = xcd_barrier_post(p.bar(), (volatile LAS unsigned*)&xb_words);
  if (p.ws == nullptr) grid.sync();
#define GSYNC() xcd_barrier(xb)
#ifdef ONLY_PH
  run_phase(p, ONLY_PH, smem); GSYNC();
  return;
#endif
  run_phase(p, 0, smem); GSYNC();
  run_phase(p, 1, smem); GSYNC();
  run_phase(p, 2, smem); GSYNC();
  run_phase(p, 3, smem); GSYNC();
  run_phase(p, 4, smem); GSYNC();
  run_phase(p, 5, smem); GSYNC();
  run_phase(p, 6, smem); GSYNC();
  run_phase(p, 7, smem); GSYNC();
  run_phase(p, 8, smem); GSYNC();
  run_phase(p, 9, smem); GSYNC();
  run_phase(p, 10, smem); GSYNC();
  run_phase(p, 11, smem); GSYNC();
  run_phase(p, 12, smem); GSYNC();
  run_phase(p, 13, smem);
}

extern "C" void kernel_launch(void* const* d_in, const int* in_sizes, int n_in, void* d_out, int out_size, void* d_ws,
                              size_t ws_size, hipStream_t stream) {
  static int grid_blocks = 0;
  if (!grid_blocks) {
    int dev = 0, cus = 0, per_cu = 0;
    hipGetDevice(&dev);
    hipDeviceGetAttribute(&cus, hipDeviceAttributeMultiprocessorCount, dev);
    hipFuncSetAttribute((const void*)mega_kernel, hipFuncAttributeMaxDynamicSharedMemorySize, LDS_BYTES);
    hipOccupancyMaxActiveBlocksPerMultiprocessor(&per_cu, (const void*)mega_kernel, 256, LDS_BYTES);
    if (per_cu < 1) per_cu = 1;
    if (per_cu > 2) per_cu = 2;
    grid_blocks = cus * per_cu;
  }
  Params p{};
  const float* const* in = (const float* const*)d_in;
  p.x = in[0]; p.mem = in[1]; p.w_in = in[2]; p.gm_ln_g = in[3]; p.gm_ln_b = in[4]; p.gm_w_s = in[5]; p.gm_b_s = in[6];
  p.w_mix_out = in[7]; p.ln1_g = in[8]; p.ln1_b = in[9]; p.mem_w_q = in[10]; p.mem_w_k = in[11]; p.mem_w_v = in[12];
  p.mem_w_o = in[13]; p.ln2_g = in[14]; p.ln2_b = in[15]; p.w_group = in[16]; p.b_group = in[17]; p.w_router = in[18];
  p.b_router = in[19]; p.w1 = in[20]; p.w3 = in[21]; p.w2 = in[22]; p.ln3_g = in[23]; p.ln3_b = in[24];
  p.out = (float*)d_out;
  p.ws = (char*)d_ws;
  if (ws_size < 756 * MB) { fprintf(stderr, "workspace too small: %zu\n", ws_size); return; }
  hipMemsetAsync((char*)d_ws + 754 * MB, 0, XCD_BAR_WORDS * sizeof(unsigned), stream);
  void* args[] = {&p};
  hipError_t e = hipLaunchCooperativeKernel((const void*)mega_kernel, dim3(grid_blocks), dim3(256), args, LDS_BYTES, stream);
  if (e != hipSuccess) fprintf(stderr, "cooperative launch failed: %s (grid %d)\n", hipGetErrorString(e), grid_blocks);
}
```

```cpp
#include <hip/hip_runtime.h>
#include <hip/hip_cooperative_groups.h>
#include <stdint.h>
#include <stdio.h>
namespace cg = cooperative_groups;

typedef unsigned short u16;
using bf16x8 = __attribute__((ext_vector_type(8))) short;
using f32x4 = __attribute__((ext_vector_type(4))) float;
using u32x4 = __attribute__((ext_vector_type(4))) unsigned int;
#define LAS __attribute__((address_space(3)))

constexpr int SEQ = 8192, DM = 2048, INW = 5120, MEML = 256;
constexpr int NEXP = 64, DEXP = 512;
constexpr float DN_ALPHA = 1.189207115002721f;
constexpr float SB_THRESH = 40.f;
constexpr int LDS_BYTES = 73728;
constexpr size_t MB = 1u << 20;

struct Params {
  const float *x, *mem, *w_in, *gm_ln_g, *gm_ln_b, *gm_w_s, *gm_b_s, *w_mix_out, *ln1_g, *ln1_b;
  const float *mem_w_q, *mem_w_k, *mem_w_v, *mem_w_o, *ln2_g, *ln2_b, *w_group, *b_group, *w_router, *b_router;
  const float *w1, *w3, *w2, *ln3_g, *ln3_b;
  float* out;
  char* ws;
#define WSP(T, name, offmb) __device__ __forceinline__ T* name() const { return (T*)(ws + (size_t)(offmb) * MB); }
  WSP(u16, WinT, 0) WSP(u16, WmixT, 20) WSP(u16, WqT, 28) WSP(u16, WkT, 36) WSP(u16, WvT, 44) WSP(u16, WoT, 52)
  WSP(u16, W1T, 60) WSP(u16, W3T, 188) WSP(u16, W2T, 316)
  WSP(u16, xb, 444)
  WSP(float, scores, 444)
  WSP(u16, memb, 476) WSP(u16, kmem, 477) WSP(u16, vmemT, 478)
  WSP(u16, proj, 479)
  WSP(u16, qm, 479)
  WSP(u16, om, 511)
  WSP(u16, yslot, 479)
  WSP(u16, mixcat, 559)
  WSP(u16, Pm, 559)
  WSP(u16, hid, 575)
  WSP(float, pre, 591)
  WSP(float, hf, 655)
  WSP(u16, hb, 719)
  WSP(int, cnt, 751)
  __device__ __forceinline__ float* gates() const { return (float*)(ws + 751 * MB + 65536); }
  WSP(int, rowlist, 752)
  WSP(unsigned, bar, 754)
  WSP(float, wgT, 755)
  WSP(float, kvpart, 756)
  __device__ __forceinline__ float* wrT() const { return (float*)(ws + 755 * MB + 65536); }
};

__device__ __forceinline__ uint32_t pack2(float a, float b);
__device__ __forceinline__ u16 f2bf(float f) { return (u16)(pack2(f, f) & 0xffffu); }
__device__ __forceinline__ float bflo(uint32_t w) { return __uint_as_float(w << 16); }
__device__ __forceinline__ float bfhi(uint32_t w) { return __uint_as_float(w & 0xffff0000u); }
typedef float f32x2_t __attribute__((ext_vector_type(2)));
typedef __bf16 bf16x2_t __attribute__((ext_vector_type(2)));
__device__ __forceinline__ uint32_t pack2(float a, float b) {
  f32x2_t v = {a, b};
  bf16x2_t r = __builtin_convertvector(v, bf16x2_t);
  return __builtin_bit_cast(uint32_t, r);
}
__device__ __forceinline__ float gelu_tanh(float x) {
  float u = 0.7978845608028654f * (x + 0.044715f * x * x * x);
  float e = __expf(2.f * u);
  float th = 1.f - 2.f / (e + 1.f);
  return 0.5f * x * (1.f + th);
}
__device__ __forceinline__ float wave_sum(float v) {
#pragma unroll
  for (int o = 32; o; o >>= 1) v += __shfl_xor(v, o);
  return v;
}
__device__ __forceinline__ float wave_max(float v) {
#pragma unroll
  for (int o = 32; o; o >>= 1) v = fmaxf(v, __shfl_xor(v, o));
  return v;
}
__device__ __forceinline__ void store_bf4(u16* dst, float a, float b, float c, float d) {
  uint2 w; w.x = pack2(a, b); w.y = pack2(c, d);
  *(uint2*)dst = w;
}

__device__ __forceinline__ void mma_128x128x64(const u16* sA, const u16* sB, f32x4 (&acc)[4][4], int wr, int wc, int fr, int fq) {
  bf16x8 af[2][4], bfr[2][4];
#pragma unroll
  for (int ks = 0; ks < 2; ks++) {
#pragma unroll
    for (int mt = 0; mt < 4; mt++) {
      int row = wr * 64 + mt * 16 + fr;
      int ch = (ks * 4 + fq) ^ ((row >> 1) & 7);
      af[ks][mt] = *(const bf16x8*)(sA + row * 64 + ch * 8);
    }
#pragma unroll
    for (int nt = 0; nt < 4; nt++) {
      int row = wc * 64 + nt * 16 + fr;
      int ch = (ks * 4 + fq) ^ ((row >> 1) & 7);
      bfr[ks][nt] = *(const bf16x8*)(sB + row * 64 + ch * 8);
    }
  }
  __builtin_amdgcn_sched_barrier(0);
  __builtin_amdgcn_s_setprio(1);
#pragma unroll
  for (int ks = 0; ks < 2; ks++)
#pragma unroll
    for (int mt = 0; mt < 4; mt++)
#pragma unroll
      for (int nt = 0; nt < 4; nt++)
        acc[mt][nt] = __builtin_amdgcn_mfma_f32_16x16x32_bf16(bfr[ks][nt], af[ks][mt], acc[mt][nt], 0, 0, 0);
  __builtin_amdgcn_s_setprio(0);
}

template <class BP, class Epi>
__device__ __forceinline__ void gemm_tile(const u16* __restrict__ A, long lda, const int* arow, int m0, BP bptr, int K,
                                          u16* smem, Epi epi) {
  const int t = threadIdx.x, lane = t & 63, wid = t >> 6, wr = wid >> 1, wc = wid & 1, fr = lane & 15, fq = lane >> 4;
  const int lr = t >> 3;
  const int gch = ((t & 7) ^ ((t >> 4) & 7)) << 3;
  const u16 *ap0, *ap1, *ap2, *ap3;
  {
    long g0 = arow ? (long)arow[lr] : (long)(m0 + lr);
    long g1 = arow ? (long)arow[lr + 32] : (long)(m0 + lr + 32);
    long g2 = arow ? (long)arow[lr + 64] : (long)(m0 + lr + 64);
    long g3 = arow ? (long)arow[lr + 96] : (long)(m0 + lr + 96);
    ap0 = A + g0 * lda + gch; ap1 = A + g1 * lda + gch; ap2 = A + g2 * lda + gch; ap3 = A + g3 * lda + gch;
  }
  const u16* bp0 = bptr(lr) + gch;
  const u16* bp1 = bptr(lr + 32) + gch;
  const u16* bp2 = bptr(lr + 64) + gch;
  const u16* bp3 = bptr(lr + 96) + gch;
  f32x4 acc[4][4];
#pragma unroll
  for (int i = 0; i < 4; i++)
#pragma unroll
    for (int j = 0; j < 4; j++) acc[i][j] = f32x4{0.f, 0.f, 0.f, 0.f};
#define GLDS(src, dst) __builtin_amdgcn_global_load_lds((const unsigned*)(src), (unsigned*)(dst), 16, 0, 0)
#define STAGE(k0, buf)                                                          \
  {                                                                             \
    u16* dA = smem + (buf) * 16384 + wid * 512;                                 \
    u16* dB = dA + 8192;                                                        \
    GLDS(ap0 + (k0), dA); GLDS(bp0 + (k0), dB);                                 \
    GLDS(ap1 + (k0), dA + 2048); GLDS(bp1 + (k0), dB + 2048);                   \
    GLDS(ap2 + (k0), dA + 4096); GLDS(bp2 + (k0), dB + 4096);                   \
    GLDS(ap3 + (k0), dA + 6144); GLDS(bp3 + (k0), dB + 6144);                   \
  }
  STAGE(0, 0);
  const int nk = K >> 6;
  for (int kt = 0; kt < nk; kt++) {
    asm volatile("s_waitcnt vmcnt(0)" ::: "memory");
    __syncthreads();
    if (kt + 1 < nk) STAGE((kt + 1) << 6, (kt + 1) & 1);
    const u16* sA = smem + (kt & 1) * 16384;
    mma_128x128x64(sA, sA + 8192, acc, wr, wc, fr, fq);
  }
#undef STAGE
#undef GLDS
#pragma unroll
  for (int mt = 0; mt < 4; mt++) epi(wr * 64 + mt * 16 + fr, wc * 64 + fq * 4, acc[mt]);
}

struct TileDesc { const u16* A; const u16* B; int m0; };
template <class Desc, class Epi>
__device__ __forceinline__ void gemm_stream(int total, long lda, long ldb, int K, u16* smem, Desc desc, Epi epi) {
  const int t = threadIdx.x, lane = t & 63, wid = t >> 6, wr = wid >> 1, wc = wid & 1, fr = lane & 15, fq = lane >> 4;
  const int lr = t >> 3;
  const int gch = ((t & 7) ^ ((t >> 4) & 7)) << 3;
  int j = blockIdx.x;
  if (j >= total) return;
  const u16 *ap, *bp;
  const long as32 = 32 * lda, bs32 = 32 * ldb;
#define SETUP(jj)                                                               \
  {                                                                             \
    TileDesc d_ = desc(jj);                                                     \
    ap = d_.A + (long)(d_.m0 + lr) * lda + gch;                                 \
    bp = d_.B + (long)lr * ldb + gch;                                           \
  }
#define GLDS(src, dst) __builtin_amdgcn_global_load_lds((const unsigned*)(src), (unsigned*)(dst), 16, 0, 0)
#define STAGE(k0, buf)                                                          \
  {                                                                             \
    u16* dA = smem + (buf) * 16384 + wid * 512;                                 \
    u16* dB = dA + 8192;                                                        \
    GLDS(ap + (k0), dA); GLDS(bp + (k0), dB);                                   \
    GLDS(ap + as32 + (k0), dA + 2048); GLDS(bp + bs32 + (k0), dB + 2048);       \
    GLDS(ap + 2 * as32 + (k0), dA + 4096); GLDS(bp + 2 * bs32 + (k0), dB + 4096); \
    GLDS(ap + 3 * as32 + (k0), dA + 6144); GLDS(bp + 3 * bs32 + (k0), dB + 6144); \
  }
  SETUP(j);
  STAGE(0, 0);
  const int nk = K >> 6;
  for (;;) {
    f32x4 acc[4][4];
#pragma unroll
    for (int i = 0; i < 4; i++)
#pragma unroll
      for (int q = 0; q < 4; q++) acc[i][q] = f32x4{0.f, 0.f, 0.f, 0.f};
    for (int kt = 0; kt < nk; kt++) {
      asm volatile("s_waitcnt vmcnt(0)" ::: "memory");
      __syncthreads();
      if (kt + 1 < nk) STAGE((kt + 1) << 6, (kt + 1) & 1);
      const u16* sA = smem + (kt & 1) * 16384;
      mma_128x128x64(sA, sA + 8192, acc, wr, wc, fr, fq);
    }
    const int jn = j + gridDim.x;
    const bool has = jn < total;
    if (has) { SETUP(jn); STAGE(0, 0); }
#pragma unroll
    for (int mt = 0; mt < 4; mt++) epi(j, wr * 64 + mt * 16 + fr, wc * 64 + fq * 4, acc[mt]);
    if (!has) break;
    j = jn;
  }
#undef SETUP
#undef STAGE
#undef GLDS
}

typedef short s16x4 __attribute__((ext_vector_type(4)));
__device__ __forceinline__ int wt_off(int k, int ch) { return 256 * k + 16 * (ch ^ (((k & 3) << 2) | ((k >> 2) & 3))); }

template <class WM, class Epi>
__device__ __forceinline__ void gemm_tile_wf32(const u16* __restrict__ A, long lda, const int* arow, WM wmap, long kstride, int K,
                                               u16* smem, Epi epi) {
  const int t = threadIdx.x, lane = t & 63, wid = t >> 6, wr = wid >> 1, wc = wid & 1, fr = lane & 15, fq = lane >> 4;
  const int lr = t >> 3;
  const int gch = ((t & 7) ^ ((t >> 4) & 7)) << 3;
  const unsigned ao0 = (unsigned)(arow[lr] * (int)lda + gch), ao1 = (unsigned)(arow[lr + 32] * (int)lda + gch);
  const unsigned ao2 = (unsigned)(arow[lr + 64] * (int)lda + gch), ao3 = (unsigned)(arow[lr + 96] * (int)lda + gch);
  const float* wp0;
  int woff0, woff1;
  {
    int kw, vw;
    wmap(kw, vw, wp0);
    woff0 = wt_off(kw, vw >> 3) + ((vw >> 2) & 1) * 8;
    woff1 = wt_off(kw + 8, vw >> 3) + ((vw >> 2) & 1) * 8;
  }
  f32x4 acc[4][4];
#pragma unroll
  for (int i = 0; i < 4; i++)
#pragma unroll
    for (int j = 0; j < 4; j++) acc[i][j] = f32x4{0.f, 0.f, 0.f, 0.f};
  f32x4 wr0[8], wr1[8];
#define GLDS(src, dst) __builtin_amdgcn_global_load_lds((const unsigned*)(src), (unsigned*)(dst), 16, 0, 0)
#define STAGE_A(k0, buf)                                                        \
  {                                                                             \
    u16* dA = smem + (buf) * 16384 + wid * 512;                                 \
    const u16* Ak = A + (k0);                                                   \
    GLDS(Ak + ao0, dA); GLDS(Ak + ao1, dA + 2048);                              \
    GLDS(Ak + ao2, dA + 4096); GLDS(Ak + ao3, dA + 6144);                       \
  }
#define LOAD_W(R, k0)                                                           \
  {                                                                             \
    _Pragma("unroll") for (int i = 0; i < 8; i++) R[i] = *(const f32x4*)(wp0 + (long)((k0) + 8 * i) * kstride); \
  }
#define WRITE_W(R, buf)                                                         \
  {                                                                             \
    char* dB = (char*)(smem + (buf) * 16384 + 8192);                            \
    _Pragma("unroll") for (int i = 0; i < 8; i++) {                             \
      uint2 w2; w2.x = pack2(R[i][0], R[i][1]); w2.y = pack2(R[i][2], R[i][3]); \
      *(uint2*)(dB + ((i & 1) ? woff1 : woff0) + 2048 * (i & ~1)) = w2;                                             \
    }                                                                           \
  }
#define COMPUTE(buf)                                                            \
  {                                                                             \
    const u16* sA = smem + (buf) * 16384;                                       \
    const char* sB = (const char*)(sA + 8192);                                  \
    _Pragma("unroll") for (int ks = 0; ks < 2; ks++) {                          \
      bf16x8 af[4], bfr[4];                                                     \
      _Pragma("unroll") for (int mt = 0; mt < 4; mt++) {                        \
        int row = wr * 64 + mt * 16 + fr;                                       \
        int ch = (ks * 4 + fq) ^ ((row >> 1) & 7);                              \
        af[mt] = *(const bf16x8*)(sA + row * 64 + ch * 8);                      \
      }                                                                         \
      _Pragma("unroll") for (int nt = 0; nt < 4; nt++) {                        \
        const int c0 = (wc * 64 + nt * 16) >> 3;                                \
        const int k0_ = ks * 32 + fq * 8 + tq;                                  \
        s16x4 lo = __builtin_amdgcn_ds_read_tr16_b64_v4i16((s16x4 LAS*)(sB + wt_off(k0_, c0 + (tp >> 1)) + 8 * (tp & 1)));     \
        s16x4 hi = __builtin_amdgcn_ds_read_tr16_b64_v4i16((s16x4 LAS*)(sB + wt_off(k0_ + 4, c0 + (tp >> 1)) + 8 * (tp & 1))); \
        bfr[nt] = bf16x8{lo[0], lo[1], lo[2], lo[3], hi[0], hi[1], hi[2], hi[3]}; \
      }                                                                         \
      _Pragma("unroll") for (int mt = 0; mt < 4; mt++)                          \
        _Pragma("unroll") for (int nt = 0; nt < 4; nt++)                        \
          acc[mt][nt] = __builtin_amdgcn_mfma_f32_16x16x32_bf16(bfr[nt], af[mt], acc[mt][nt], 0, 0, 0); \
    }                                                                           \
  }
  const int tq = fr >> 2, tp = fr & 3;
  const int trb = wt_off(fq * 8 + tq, wc * 8 + (tp >> 1)) + 8 * (tp & 1);
  const int nk = K >> 6;
  STAGE_A(0, 0);
  LOAD_W(wr0, 0);
  LOAD_W(wr1, 64);
  WRITE_W(wr0, 0);
  for (int kt = 0; kt < nk; kt += 2) {
    asm volatile("s_waitcnt vmcnt(8)" ::: "memory");
    __syncthreads();
    STAGE_A((kt + 1) << 6, 1);
    if (kt + 2 < nk) LOAD_W(wr0, (kt + 2) << 6);
    COMPUTE(0);
    WRITE_W(wr1, 1);
    if (kt + 2 < nk) { asm volatile("s_waitcnt vmcnt(8)" ::: "memory"); } else { asm volatile("s_waitcnt vmcnt(0)" ::: "memory"); }
    __syncthreads();
    if (kt + 2 < nk) { STAGE_A((kt + 2) << 6, 0); }
    if (kt + 3 < nk) LOAD_W(wr1, (kt + 3) << 6);
    COMPUTE(1);
    if (kt + 2 < nk) WRITE_W(wr0, 0);
  }
#undef STAGE_A
#undef LOAD_W
#undef WRITE_W
#undef COMPUTE
#undef GLDS
#pragma unroll
  for (int mt = 0; mt < 4; mt++) epi(wr * 64 + mt * 16 + fr, wc * 64 + fq * 4, acc[mt]);
}

__device__ __forceinline__ void transpose_tile(const float* __restrict__ src, u16* __restrict__ dst, int R, int C, int tr, int tc, u16* lds) {
  const int t = threadIdx.x;
#pragma unroll
  for (int i = 0; i < 4; i++) {
    int r = (t >> 4) + 16 * i, c4 = (t & 15) * 4;
    float4 v = *(const float4*)(src + (long)(tr * 64 + r) * C + tc * 64 + c4);
    lds[(c4 + 0) * 66 + r] = f2bf(v.x);
    lds[(c4 + 1) * 66 + r] = f2bf(v.y);
    lds[(c4 + 2) * 66 + r] = f2bf(v.z);
    lds[(c4 + 3) * 66 + r] = f2bf(v.w);
  }
  __syncthreads();
  {
    int n = t >> 2, k0 = (t & 3) * 16;
    const uint32_t* s32 = (const uint32_t*)(lds + n * 66 + k0);
    uint4 a, b;
    a.x = s32[0]; a.y = s32[1]; a.z = s32[2]; a.w = s32[3];
    b.x = s32[4]; b.y = s32[5]; b.z = s32[6]; b.w = s32[7];
    u16* d = dst + (long)(tc * 64 + n) * R + tr * 64 + k0;
    *(uint4*)d = a;
    *(uint4*)(d + 8) = b;
  }
  __syncthreads();
}

__device__ void phase_convert(const Params& p, u16* smem) {
  const int nb = gridDim.x, bid = blockIdx.x, t = threadIdx.x;
  if (bid == 0 && t < NEXP) p.cnt()[t * 32] = 0;
  for (int i = bid * 256 + t; i < 9 * 8 * DM; i += nb * 256) {
    int G = i / (8 * DM), rem = i % (8 * DM), e = rem / DM, d = rem % DM;
    if (G == 0) p.wgT()[e * DM + d] = p.w_group[d * 8 + e];
    else p.wrT()[((G - 1) * 8 + e) * DM + d] = p.w_router[((long)(G - 1) * DM + d) * 8 + e];
  }
  {
    const long n4x = (long)SEQ * DM / 4, n4m = (long)MEML * DM / 4;
    for (long i = (long)bid * 256 + t; i < n4x + n4m; i += (long)nb * 256) {
      const float* s; u16* d; long j;
      if (i < n4x) { s = p.x; d = p.xb(); j = i; } else { s = p.mem; d = p.memb(); j = i - n4x; }
      float4 v = *(const float4*)(s + j * 4);
      store_bf4(d + j * 4, v.x, v.y, v.z, v.w);
    }
  }
  const int T_IN = 2560, T_SQ = 1024;
  const int total = T_IN + 5 * T_SQ;
  for (int j = bid; j < total; j += nb) {
    const float* src; u16* dst; int R, C, tl;
    if (j < T_IN) { src = p.w_in; dst = p.WinT(); R = DM; C = INW; tl = j; }
    else {
      int q = (j - T_IN) / T_SQ; tl = (j - T_IN) % T_SQ; R = DM; C = DM;
      src = q == 0 ? p.w_mix_out : q == 1 ? p.mem_w_q : q == 2 ? p.mem_w_k : q == 3 ? p.mem_w_v : p.mem_w_o;
      dst = q == 0 ? p.WmixT() : q == 1 ? p.WqT() : q == 2 ? p.WkT() : q == 3 ? p.WvT() : p.WoT();
    }
    int ntc = C / 64;
    transpose_tile(src, dst, R, C, tl / ntc, tl % ntc, smem);
  }
}

__device__ void phase_inproj(const Params& p, u16* smem) {
  const int MT = SEQ / 128, NT = INW / 128;
  const u16* xb = p.xb(); const u16* WinT = p.WinT(); u16* proj = p.proj();
  gemm_stream(MT * NT, DM, DM, DM, smem,
              [&](int j) { int mt = j % MT, nt = j / MT; TileDesc d; d.A = xb; d.B = WinT + (long)nt * 128 * DM; d.m0 = mt * 128; return d; },
              [&](int j, int m, int nb, f32x4 (&a)[4]) {
                int mt = j % MT, nt = j / MT;
                int seg = nt >> 3;
                u16* outp = proj + (long)(mt * 128 + m) * INW + nt * 128 + nb;
#pragma unroll
                for (int q = 0; q < 4; q++) {
                  float v0 = a[q][0], v1 = a[q][1], v2 = a[q][2], v3 = a[q][3];
                  if (seg < 2) { v0 = gelu_tanh(v0); v1 = gelu_tanh(v1); v2 = gelu_tanh(v2); v3 = gelu_tanh(v3); }
                  else if (seg == 2) { const float sc = 0.08838834764831845f; v0 *= sc; v1 *= sc; v2 *= sc; v3 *= sc; }
                  store_bf4(outp + q * 16, v0, v1, v2, v3);
                }
              });
}

__device__ void memkv_tile(const Params& p, int item, u16* smem) {
  const int jj = item >> 2, kc = item & 3;
  int which = jj / 32, r_ = jj % 32, mt = r_ & 1, nt = r_ >> 1;
  const u16* W = (which == 0 ? p.WkT() : p.WvT()) + (long)nt * 128 * DM + kc * 512;
  float* outp = p.kvpart() + ((long)kc * MEML + mt * 128) * 4096 + which * 2048 + nt * 128;
  gemm_tile(p.memb() + kc * 512, DM, nullptr, mt * 128, [&](int r) { return W + (long)r * DM; }, 512, smem,
            [&](int m, int nb, f32x4 (&a)[4]) {
#pragma unroll
              for (int q = 0; q < 4; q++) *(f32x4*)(outp + (long)m * 4096 + nb + q * 16) = a[q];
            });
  __syncthreads();
}

__device__ void memkv_reduce(const Params& p) {
  const float* part = p.kvpart();
  for (int i = blockIdx.x * 256 + threadIdx.x; i < MEML * 4096 / 4; i += gridDim.x * 256) {
    const int m = i >> 10, n = (i & 1023) * 4;
    f32x4 v = *(const f32x4*)(part + (long)m * 4096 + n);
#pragma unroll
    for (int kc = 1; kc < 4; kc++) v += *(const f32x4*)(part + ((long)kc * MEML + m) * 4096 + n);
    if (n < 2048) store_bf4(p.kmem() + (long)m * DM + n, v[0], v[1], v[2], v[3]);
    else {
#pragma unroll
      for (int e = 0; e < 4; e++) p.vmemT()[(long)(n - 2048 + e) * MEML + m] = f2bf(v[e]);
    }
  }
}

__device__ void gmlp_item(const Params& p, int nb, int g, u16* smem) {
  const int t = threadIdx.x, lane = t & 63, wid = t >> 6, wr = wid >> 1, wc = wid & 1, fr = lane & 15, fq = lane >> 4;
  u16* sA = smem;
  u16* sB = smem + 16384;
#pragma unroll
  for (int i = 0; i < 8; i++) {
    int q = t + 256 * i;
    int tt = q >> 4, sc = q & 15, kt = sc >> 3, c = sc & 7;
    const float* src = p.gm_w_s + ((long)g * 128 + tt) * 128 + sc * 8;
    float4 a = *(const float4*)src, b = *(const float4*)(src + 4);
    bool keep = (tt >> 6) >= kt;
    uint4 w;
    w.x = keep ? pack2(a.x, a.y) : 0u; w.y = keep ? pack2(a.z, a.w) : 0u;
    w.z = keep ? pack2(b.x, b.y) : 0u; w.w = keep ? pack2(b.z, b.w) : 0u;
    *(uint4*)(sA + kt * 8192 + tt * 64 + ((c ^ ((tt >> 1) & 7)) << 3)) = w;
  }
  {
    const int s = t >> 1, half = t & 1;
    const u16* vp = p.proj() + (long)(nb * 128 + s) * INW + 1024 + g * 128 + half * 64;
    float v[64];
#pragma unroll
    for (int i = 0; i < 8; i++) {
      uint4 w = *(const uint4*)(vp + i * 8);
      v[i * 8 + 0] = bflo(w.x); v[i * 8 + 1] = bfhi(w.x); v[i * 8 + 2] = bflo(w.y); v[i * 8 + 3] = bfhi(w.y);
      v[i * 8 + 4] = bflo(w.z); v[i * 8 + 5] = bfhi(w.z); v[i * 8 + 6] = bflo(w.w); v[i * 8 + 7] = bfhi(w.w);
    }
    float sum = 0.f;
#pragma unroll
    for (int i = 0; i < 64; i++) sum += v[i];
    sum += __shfl_xor(sum, 1);
    const float mean = sum * (1.f / 128.f);
    float sq = 0.f;
#pragma unroll
    for (int i = 0; i < 64; i++) { float d = v[i] - mean; sq += d * d; }
    sq += __shfl_xor(sq, 1);
    const float rstd = rsqrtf(sq * (1.f / 128.f) + 1e-5f);
    const int kt = s >> 6, kk = s & 63;
    const float* lg = p.gm_ln_g + g * 128 + half * 64;
    const float* lb = p.gm_ln_b + g * 128 + half * 64;
#pragma unroll
    for (int i = 0; i < 64; i++) {
      int cc = half * 64 + i;
      float val = (v[i] - mean) * rstd * lg[i] + lb[i];
      sB[kt * 8192 + cc * 64 + (((kk >> 3) ^ ((cc >> 1) & 7)) << 3) + (kk & 7)] = f2bf(val);
    }
  }
  __syncthreads();
  f32x4 acc[4][4];
#pragma unroll
  for (int i = 0; i < 4; i++)
#pragma unroll
    for (int j = 0; j < 4; j++) acc[i][j] = f32x4{0.f, 0.f, 0.f, 0.f};
  mma_128x128x64(sA, sB, acc, wr, wc, fr, fq);
  mma_128x128x64(sA + 8192, sB + 8192, acc, wr, wc, fr, fq);
#pragma unroll
  for (int mt = 0; mt < 4; mt++) {
    int m = wr * 64 + mt * 16 + fr;
    float bs = p.gm_b_s[g * 128 + m];
    const u16* up = p.proj() + (long)(nb * 128 + m) * INW + g * 128;
    u16* op = p.mixcat() + (long)(nb * 128 + m) * DM + g * 128;
#pragma unroll
    for (int nt = 0; nt < 4; nt++) {
      int n = wc * 64 + nt * 16 + fq * 4;
      uint2 uw = *(const uint2*)(up + n);
      f32x4 a = acc[mt][nt];
      store_bf4(op + n, bflo(uw.x) * (a[0] + bs), bfhi(uw.x) * (a[1] + bs), bflo(uw.y) * (a[2] + bs), bfhi(uw.y) * (a[3] + bs));
    }
  }
  __syncthreads();
}

__device__ void attn_item(const Params& p, int h, int qt, u16* smem) {
  u16* sK = smem;
  u16* sP = smem;
  u16* sVt = smem + 8192;
  float* sS = (float*)(smem + 16384);
  const int t = threadIdx.x, lane = t & 63, w = t >> 6, fr = lane & 15, fq = lane >> 4;
  const int q0 = qt * 128;
  const u16* Qb = p.proj() + 2048 + h * 128;
  const u16* Kb = p.proj() + 3072 + h * 128;
  const u16* Vb = p.proj() + 4096 + h * 128;
  f32x4 o[2][8];
#pragma unroll
  for (int i = 0; i < 2; i++)
#pragma unroll
    for (int j = 0; j < 8; j++) o[i][j] = f32x4{0.f, 0.f, 0.f, 0.f};
  const int srow = t >> 1, half = t & 1;
  const int qg = q0 + srow;
  float crow = 0.f;
  for (int kb = qt * 2 + 1; kb >= 0; kb--) {
    bf16x8 qf[2][4];
#pragma unroll
    for (int mt = 0; mt < 2; mt++)
#pragma unroll
      for (int ks = 0; ks < 4; ks++)
        qf[mt][ks] = *(const bf16x8*)(Qb + (long)(q0 + w * 32 + mt * 16 + fr) * INW + ks * 32 + fq * 8);
#pragma unroll
    for (int i = 0; i < 4; i++) {
      int idx = t + 256 * i;
      int key = idx >> 4, ch = idx & 15;
      uint4 kv = *(const uint4*)(Kb + (long)(kb * 64 + key) * INW + ch * 8);
      *(uint4*)(sK + key * 128 + ((ch ^ (key & 15)) << 3)) = kv;
      uint4 vv = *(const uint4*)(Vb + (long)(kb * 64 + key) * INW + ch * 8);
      *(uint4*)((char*)sVt + wt_off(key, ch)) = vv;
    }
    __syncthreads();
#pragma unroll
    for (int nt = 0; nt < 4; nt++) {
      f32x4 s0 = f32x4{0.f, 0.f, 0.f, 0.f}, s1 = f32x4{0.f, 0.f, 0.f, 0.f};
      const int krow = nt * 16 + fr;
#pragma unroll
      for (int ks = 0; ks < 4; ks++) {
        bf16x8 kf = *(const bf16x8*)(sK + krow * 128 + (((ks * 4 + fq) ^ (krow & 15)) << 3));
        s0 = __builtin_amdgcn_mfma_f32_16x16x32_bf16(kf, qf[0][ks], s0, 0, 0, 0);
        s1 = __builtin_amdgcn_mfma_f32_16x16x32_bf16(kf, qf[1][ks], s1, 0, 0, 0);
      }
      *(f32x4*)(sS + (w * 32 + fr) * 68 + nt * 16 + fq * 4) = s0;
      *(f32x4*)(sS + (w * 32 + 16 + fr) * 68 + nt * 16 + fq * 4) = s1;
    }
    __syncthreads();
    {
      float z[32];
      float* srp = sS + srow * 68 + half * 32;
#pragma unroll
      for (int j4 = 0; j4 < 8; j4++) {
        f32x4 v = *(const f32x4*)(srp + j4 * 4);
        z[j4 * 4 + 0] = v[0]; z[j4 * 4 + 1] = v[1]; z[j4 * 4 + 2] = v[2]; z[j4 * 4 + 3] = v[3];
      }
      const int kbase = kb * 64 + half * 32;
      float tot = 0.f;
#pragma unroll
      for (int j4 = 0; j4 < 8; j4++) {
        f32x4 sv;
#pragma unroll
        for (int e = 0; e < 4; e++) {
          const int j = j4 * 4 + e;
          bool valid = (kbase + j) < qg;
          float zz = z[j];
          float s = valid ? (fmaxf(zz, 0.f) + __logf(1.f + __expf(-fabsf(zz)))) : 0.f;
          sv[e] = s;
          tot += s;
          z[j] = zz - s;
        }
        *(f32x4*)(srp + j4 * 4) = sv;
      }
      const float ptot = __shfl_xor(tot, 1);
      float c = crow + (half == 0 ? ptot : 0.f);
#pragma unroll
      for (int j4 = 7; j4 >= 0; j4--) {
        f32x4 sv = *(const f32x4*)(srp + j4 * 4);
#pragma unroll
        for (int e = 3; e >= 0; e--) {
          const int j = j4 * 4 + e;
          bool valid = (kbase + j) < qg;
          float a = valid ? __expf(z[j] - c) : 0.f;
          c += sv[e];
          z[j] = a;
        }
      }
      crow += tot + ptot;
#pragma unroll
      for (int q = 0; q < 4; q++) {
        uint4 wv;
        wv.x = pack2(z[q * 8 + 0], z[q * 8 + 1]); wv.y = pack2(z[q * 8 + 2], z[q * 8 + 3]);
        wv.z = pack2(z[q * 8 + 4], z[q * 8 + 5]); wv.w = pack2(z[q * 8 + 6], z[q * 8 + 7]);
        *(uint4*)(sP + srow * 64 + (((half * 4 + q) ^ ((srow >> 1) & 7)) << 3)) = wv;
      }
    }
    const int done = __syncthreads_and(crow > SB_THRESH);
#pragma unroll
    for (int ks = 0; ks < 2; ks++) {
      bf16x8 pf[2];
#pragma unroll
      for (int mt = 0; mt < 2; mt++) {
        int row = w * 32 + mt * 16 + fr;
        pf[mt] = *(const bf16x8*)(sP + row * 64 + (((ks * 4 + fq) ^ ((row >> 1) & 7)) << 3));
      }
#pragma unroll
      for (int nt = 0; nt < 8; nt++) {
        const int vk0 = ks * 32 + fq * 8 + (fr >> 2), vc = nt * 2 + ((fr & 3) >> 1), vb8 = 8 * (fr & 1);
        s16x4 vlo = __builtin_amdgcn_ds_read_tr16_b64_v4i16((s16x4 LAS*)((const char*)sVt + wt_off(vk0, vc) + vb8));
        s16x4 vhi = __builtin_amdgcn_ds_read_tr16_b64_v4i16((s16x4 LAS*)((const char*)sVt + wt_off(vk0 + 4, vc) + vb8));
        bf16x8 vf = bf16x8{vlo[0], vlo[1], vlo[2], vlo[3], vhi[0], vhi[1], vhi[2], vhi[3]};
        o[0][nt] = __builtin_amdgcn_mfma_f32_16x16x32_bf16(vf, pf[0], o[0][nt], 0, 0, 0);
        o[1][nt] = __builtin_amdgcn_mfma_f32_16x16x32_bf16(vf, pf[1], o[1][nt], 0, 0, 0);
      }
    }
    __syncthreads();
    if (done) break;
  }
#pragma unroll
  for (int mt = 0; mt < 2; mt++) {
    u16* op = p.mixcat() + (long)(q0 + w * 32 + mt * 16 + fr) * DM + 1024 + h * 128;
#pragma unroll
    for (int nt = 0; nt < 8; nt++) {
      f32x4 a = o[mt][nt];
      store_bf4(op + nt * 16 + fq * 4, a[0], a[1], a[2], a[3]);
    }
  }
}

__device__ void phase_mix(const Params& p, u16* smem) {
  const int NA = 8 * 64, NG = 64 * 8;
#ifndef NO_ATTN
  for (int j = blockIdx.x; j < NA; j += gridDim.x) { int qt = 63 - (j >> 3), h = j & 7; attn_item(p, h, qt, smem); }
#endif
#ifndef NO_GMLP
  for (int j = blockIdx.x; j < NG; j += gridDim.x) gmlp_item(p, j >> 3, j & 7, smem);
#endif
  for (int j = gridDim.x - 1 - blockIdx.x; j < 256; j += gridDim.x) memkv_tile(p, j, smem);
}

template <bool RES_BF16>
__device__ __forceinline__ void gemm_residual(const u16* A, const u16* WT, const void* res_, float* pre, u16* smem) {
  const int MT = SEQ / 128, NT = DM / 128;
  gemm_stream(MT * NT, DM, DM, DM, smem,
              [&](int j) { int mt = j % MT, nt = j / MT; TileDesc d; d.A = A; d.B = WT + (long)nt * 128 * DM; d.m0 = mt * 128; return d; },
              [&](int j, int m, int nb, f32x4 (&a)[4]) {
                int mt = j % MT, nt = j / MT;
                const long off = (long)(mt * 128 + m) * DM + nt * 128 + nb;
#pragma unroll
                for (int q = 0; q < 4; q++) {
                  float4 xv;
                  if (RES_BF16) {
                    uint2 xw = *(const uint2*)((const u16*)res_ + off + q * 16);
                    xv.x = bflo(xw.x); xv.y = bfhi(xw.x); xv.z = bflo(xw.y); xv.w = bfhi(xw.y);
                  } else {
                    xv = *(const float4*)((const float*)res_ + off + q * 16);
                  }
                  float4 r; r.x = DN_ALPHA * xv.x + a[q][0]; r.y = DN_ALPHA * xv.y + a[q][1]; r.z = DN_ALPHA * xv.z + a[q][2]; r.w = DN_ALPHA * xv.w + a[q][3];
                  *(float4*)(pre + off + q * 16) = r;
                }
              });
}
__device__ void phase_mixout(const Params& p, u16* smem) { gemm_residual<false>(p.mixcat(), p.WmixT(), p.x, p.pre(), smem); }
__device__ void phase_oproj(const Params& p, u16* smem) { gemm_residual<true>(p.om(), p.WoT(), p.hb(), p.pre(), smem); }

__device__ void phase_qproj(const Params& p, u16* smem) {
  const int MT = SEQ / 128, NT = DM / 128;
  const u16* hb = p.hb(); const u16* WqT = p.WqT(); u16* qm = p.qm();
  gemm_stream(MT * NT, DM, DM, DM, smem,
              [&](int j) { int mt = j % MT, nt = j / MT; TileDesc d; d.A = hb; d.B = WqT + (long)nt * 128 * DM; d.m0 = mt * 128; return d; },
              [&](int j, int m, int nb, f32x4 (&a)[4]) {
                int mt = j % MT, nt = j / MT;
                u16* outp = qm + (long)(mt * 128 + m) * DM + nt * 128 + nb;
                const float sc = 0.04419417382415922f;
#pragma unroll
                for (int q = 0; q < 4; q++) store_bf4(outp + q * 16, a[q][0] * sc, a[q][1] * sc, a[q][2] * sc, a[q][3] * sc);
              });
}

__device__ void phase_scores(const Params& p, u16* smem) {
  const int MT = SEQ / 128;
  const u16* qm = p.qm(); const u16* kmem = p.kmem(); float* scores = p.scores();
  gemm_stream(4 * MT * 2, DM, DM, 512, smem,
              [&](int j) { int mt = j % MT, r_ = j / MT, nt = r_ & 1, h = r_ >> 1; TileDesc d; d.A = qm + h * 512; d.B = kmem + (long)nt * 128 * DM + h * 512; d.m0 = mt * 128; return d; },
              [&](int j, int m, int nb, f32x4 (&a)[4]) {
                int mt = j % MT, r_ = j / MT, nt = r_ & 1, h = r_ >> 1;
                float* outp = scores + ((long)h * SEQ + mt * 128 + m) * MEML + nt * 128 + nb;
#pragma unroll
                for (int q = 0; q < 4; q++) {
                  float4 r4; r4.x = a[q][0]; r4.y = a[q][1]; r4.z = a[q][2]; r4.w = a[q][3];
                  *(float4*)(outp + q * 16) = r4;
                }
              });
}

__device__ void phase_softmax(const Params& p) {
  const int wpb = 4, lane = threadIdx.x & 63, wid = threadIdx.x >> 6;
  const int nrows = 4 * SEQ;
  for (int r = blockIdx.x * wpb + wid; r < nrows; r += gridDim.x * wpb) {
    float4 v = *(const float4*)(p.scores() + (long)r * MEML + lane * 4);
    float mx = wave_max(fmaxf(fmaxf(v.x, v.y), fmaxf(v.z, v.w)));
    float e0 = __expf(v.x - mx), e1 = __expf(v.y - mx), e2 = __expf(v.z - mx), e3 = __expf(v.w - mx);
    float inv = 1.f / wave_sum(e0 + e1 + e2 + e3);
    store_bf4(p.Pm() + (long)r * MEML + lane * 4, e0 * inv, e1 * inv, e2 * inv, e3 * inv);
  }
}

__device__ void phase_pv(const Params& p, u16* smem) {
  const int MT = SEQ / 128;
  const u16* Pm = p.Pm(); const u16* vmemT = p.vmemT(); u16* om = p.om();
  gemm_stream(4 * MT * 4, MEML, MEML, MEML, smem,
              [&](int j) { int mt = j % MT, r_ = j / MT, nt = r_ & 3, h = r_ >> 2; TileDesc d; d.A = Pm + (long)h * SEQ * MEML; d.B = vmemT + (long)(h * 512 + nt * 128) * MEML; d.m0 = mt * 128; return d; },
              [&](int j, int m, int nb, f32x4 (&a)[4]) {
                int mt = j % MT, r_ = j / MT, nt = r_ & 3, h = r_ >> 2;
                u16* outp = om + (long)(mt * 128 + m) * DM + h * 512 + nt * 128 + nb;
#pragma unroll
                for (int q = 0; q < 4; q++) store_bf4(outp + q * 16, a[q][0], a[q][1], a[q][2], a[q][3]);
              });
}

__device__ __forceinline__ void ln_stats(const float (&v)[32], float& mean, float& rstd) {
  float s = 0.f;
#pragma unroll
  for (int i = 0; i < 32; i++) s += v[i];
  mean = wave_sum(s) * (1.f / DM);
  float q = 0.f;
#pragma unroll
  for (int i = 0; i < 32; i++) { float d = v[i] - mean; q += d * d; }
  rstd = rsqrtf(wave_sum(q) * (1.f / DM) + 1e-5f);
}

typedef const f32x4 __attribute__((address_space(1)))* g_cv4;
typedef f32x4 __attribute__((address_space(1)))* g_v4;
typedef unsigned int u32x2 __attribute__((ext_vector_type(2)));
typedef const u32x2 __attribute__((address_space(1)))* g_cu2;
typedef u32x2 __attribute__((address_space(1)))* g_u2;
template <class G, class T> __device__ __forceinline__ G opaque_g(T* q) { asm volatile("" : "+v"(q)); return (G)q; }

template <int MODE>
__device__ void phase_ln(const Params& p, u16* smem) {
  const int lane = threadIdx.x & 63, wid = threadIdx.x >> 6;
  const float* gam = MODE == 0 ? p.ln1_g : p.ln3_g;
  const float* bet = MODE == 0 ? p.ln1_b : p.ln3_b;
  for (int rb = (blockIdx.x * 4 + wid) * 2; rb < SEQ; rb += gridDim.x * 8) {
    float v[2][32];
#pragma unroll
    for (int q = 0; q < 2; q++) {
      const int r = rb + q;
      if (MODE == 0) {
        g_cv4 pr = opaque_g<g_cv4>(p.pre() + (long)r * DM + lane * 4);
#pragma unroll
        for (int i = 0; i < 8; i++) {
          f32x4 a = pr[i * 64];
          v[q][i * 4 + 0] = a[0]; v[q][i * 4 + 1] = a[1]; v[q][i * 4 + 2] = a[2]; v[q][i * 4 + 3] = a[3];
        }
      } else {
        g_cu2 ph = opaque_g<g_cu2>(p.hb() + (long)r * DM + lane * 4);
        g_cu2 py0 = opaque_g<g_cu2>(p.yslot() + (long)(2 * r) * DM + lane * 4);
        g_cu2 py1 = opaque_g<g_cu2>(p.yslot() + (long)(2 * r + 1) * DM + lane * 4);
#pragma unroll
        for (int i = 0; i < 8; i++) {
          u32x2 hw = ph[i * 64], y0 = py0[i * 64], y1 = py1[i * 64];
          v[q][i * 4 + 0] = DN_ALPHA * bflo(hw[0]) + (bflo(y0[0]) + bflo(y1[0]));
          v[q][i * 4 + 1] = DN_ALPHA * bfhi(hw[0]) + (bfhi(y0[0]) + bfhi(y1[0]));
          v[q][i * 4 + 2] = DN_ALPHA * bflo(hw[1]) + (bflo(y0[1]) + bflo(y1[1]));
          v[q][i * 4 + 3] = DN_ALPHA * bfhi(hw[1]) + (bfhi(y0[1]) + bfhi(y1[1]));
        }
      }
    }
    float mean[2], rstd[2];
    ln_stats(v[0], mean[0], rstd[0]);
    ln_stats(v[1], mean[1], rstd[1]);
    g_cv4 pg = opaque_g<g_cv4>(gam + lane * 4);
    g_cv4 pb = opaque_g<g_cv4>(bet + lane * 4);
#pragma unroll
    for (int q = 0; q < 2; q++) {
      g_v4 po = opaque_g<g_v4>(p.out + (long)(rb + q) * DM + lane * 4);
      g_u2 ph = opaque_g<g_u2>(p.hb() + (long)(rb + q) * DM + lane * 4);
#pragma unroll
      for (int i = 0; i < 8; i++) {
        f32x4 g = pg[i * 64], b = pb[i * 64];
        f32x4 o4;
#pragma unroll
        for (int e = 0; e < 4; e++) o4[e] = (v[q][i * 4 + e] - mean[q]) * rstd[q] * g[e] + b[e];
        if (MODE == 2) po[i * 64] = o4;
        else { u32x2 w = {pack2(o4[0], o4[1]), pack2(o4[2], o4[3])}; ph[i * 64] = w; }
      }
    }
  }
}

typedef const f32x4 __attribute__((address_space(1)))* gv4p;
__device__ __forceinline__ gv4p launder_g(const float* q) { asm volatile("" : "+v"(q)); return (gv4p)q; }

__device__ __forceinline__ void wave_reduce8(float (&a)[8], int lane) {
  float b[4], c[2], d;
  const bool h5 = lane & 32, h4 = lane & 16, h3 = lane & 8;
#pragma unroll
  for (int k = 0; k < 4; k++) {
    float send = h5 ? a[k] : a[k + 4];
    float keep = h5 ? a[k + 4] : a[k];
    b[k] = keep + __shfl_xor(send, 32);
  }
#pragma unroll
  for (int k = 0; k < 2; k++) {
    float send = h4 ? b[k] : b[k + 2];
    float keep = h4 ? b[k + 2] : b[k];
    c[k] = keep + __shfl_xor(send, 16);
  }
  {
    float send = h3 ? c[0] : c[1];
    float keep = h3 ? c[1] : c[0];
    d = keep + __shfl_xor(send, 8);
  }
  d += __shfl_xor(d, 4);
  d += __shfl_xor(d, 2);
  d += __shfl_xor(d, 1);
#pragma unroll
  for (int g = 0; g < 8; g++) a[g] = __shfl(d, ((g >> 2) & 1) * 32 + ((g >> 1) & 1) * 16 + (g & 1) * 8);
}

__device__ void phase_ln2_route(const Params& p) {
  const int lane = threadIdx.x & 63, wid = threadIdx.x >> 6;
  const float* wgT = p.wgT();
  const float* wrT = p.wrT();
#define CH(i) ((i) * 256)
  for (int rb = (blockIdx.x * 4 + wid) * 2; rb < SEQ; rb += gridDim.x * 8) {
    float v[2][32];
#pragma unroll
    for (int q = 0; q < 2; q++)
#pragma unroll
      for (int i = 0; i < 8; i++) {
        f32x4 a = *(const f32x4*)(p.pre() + (long)(rb + q) * DM + CH(i) + lane * 4);
        v[q][i * 4 + 0] = a[0]; v[q][i * 4 + 1] = a[1]; v[q][i * 4 + 2] = a[2]; v[q][i * 4 + 3] = a[3];
      }
    float mean[2], rstd[2];
    ln_stats(v[0], mean[0], rstd[0]);
    ln_stats(v[1], mean[1], rstd[1]);
#pragma unroll
    for (int i = 0; i < 8; i++) {
      int c = CH(i) + lane * 4;
      f32x4 g = *(const f32x4*)(p.ln2_g + c), b = *(const f32x4*)(p.ln2_b + c);
#pragma unroll
      for (int q = 0; q < 2; q++) {
        f32x4 o4;
#pragma unroll
        for (int e = 0; e < 4; e++) { o4[e] = (v[q][i * 4 + e] - mean[q]) * rstd[q] * g[e] + b[e]; v[q][i * 4 + e] = o4[e]; }
        store_bf4(p.hb() + (long)(rb + q) * DM + c, o4[0], o4[1], o4[2], o4[3]);
      }
    }
    float lg[2][8];
    {
      f32x4 wb[2][8];
      {
        gv4p wp = launder_g(wgT + lane * 4);
#pragma unroll
        for (int i = 0; i < 8; i++) wb[0][i] = wp[CH(i) >> 2];
      }
#pragma unroll
      for (int g = 0; g < 8; g++) {
        if (g + 1 < 8) {
          gv4p wp = launder_g(wgT + (g + 1) * DM + lane * 4);
#pragma unroll
          for (int i = 0; i < 8; i++) wb[(g + 1) & 1][i] = wp[CH(i) >> 2];
        }
        __builtin_amdgcn_sched_barrier(0);
        float s0 = 0.f, s1 = 0.f;
#pragma unroll
        for (int i = 0; i < 8; i++)
#pragma unroll
          for (int e = 0; e < 4; e++) { s0 += wb[g & 1][i][e] * v[0][i * 4 + e]; s1 += wb[g & 1][i][e] * v[1][i * 4 + e]; }
        lg[0][g] = s0; lg[1][g] = s1;
        __builtin_amdgcn_sched_barrier(0);
      }
    }
    wave_reduce8(lg[0], lane);
    wave_reduce8(lg[1], lane);
    int gi[2]; float gval[2];
#pragma unroll
    for (int q = 0; q < 2; q++) {
#pragma unroll
      for (int g = 0; g < 8; g++) lg[q][g] += p.b_group[g];
      int bi = 0; float gm = lg[q][0];
#pragma unroll
      for (int g = 1; g < 8; g++) if (lg[q][g] > gm) { gm = lg[q][g]; bi = g; }
      float gs = 0.f;
#pragma unroll
      for (int g = 0; g < 8; g++) gs += __expf(lg[q][g] - gm);
      gval[q] = 1.f / gs;
      gi[q] = __builtin_amdgcn_readfirstlane(bi);
    }
    float le[2][8];
    {
      const float* wr0_ = wrT + (long)gi[0] * 8 * DM;
      const float* wr1_ = wrT + (long)gi[1] * 8 * DM;
      f32x4 wb[2][8];
      {
        gv4p wp = launder_g(wr0_ + lane * 4);
#pragma unroll
        for (int i = 0; i < 8; i++) wb[0][i] = wp[CH(i) >> 2];
      }
#pragma unroll
      for (int u = 0; u < 16; u++) {
        if (u + 1 < 16) {
          gv4p wp = launder_g((((u + 1) >> 3) ? wr1_ : wr0_) + ((u + 1) & 7) * DM + lane * 4);
#pragma unroll
          for (int i = 0; i < 8; i++) wb[(u + 1) & 1][i] = wp[CH(i) >> 2];
        }
        __builtin_amdgcn_sched_barrier(0);
        float s0 = 0.f;
#pragma unroll
        for (int i = 0; i < 8; i++)
#pragma unroll
          for (int e = 0; e < 4; e++) s0 += wb[u & 1][i][e] * v[u >> 3][i * 4 + e];
        le[u >> 3][u & 7] = s0;
        __builtin_amdgcn_sched_barrier(0);
      }
    }
    wave_reduce8(le[0], lane);
    wave_reduce8(le[1], lane);
#pragma unroll
    for (int q = 0; q < 2; q++) {
#pragma unroll
      for (int g = 0; g < 8; g++) le[q][g] += p.b_router[gi[q] * 8 + g];
      int i1 = 0; float v1 = le[q][0];
#pragma unroll
      for (int g = 1; g < 8; g++) if (le[q][g] > v1) { v1 = le[q][g]; i1 = g; }
      int i2 = 0; float v2 = -3.0e38f;
#pragma unroll
      for (int g = 0; g < 8; g++) if (g != i1 && le[q][g] > v2) { v2 = le[q][g]; i2 = g; }
      float e2 = __expf(v2 - v1);
      float g1 = gval[q] / (1.f + e2), g2 = gval[q] * e2 / (1.f + e2);
      if (lane == 0) {
        const int r = rb + q;
        int ea = gi[q] * 8 + i1, eb = gi[q] * 8 + i2;
        int pa = atomicAdd(&p.cnt()[ea * 32], 1);
        p.rowlist()[ea * SEQ + pa] = 2 * r;
        p.gates()[2 * r] = g1;
        int pb = atomicAdd(&p.cnt()[eb * 32], 1);
        p.rowlist()[eb * SEQ + pb] = 2 * r + 1;
        p.gates()[2 * r + 1] = g2;
      }
    }
  }
}
#undef CH

template <int STAGE>
__device__ void phase_moe(const Params& p, u16* smem) {
  int* sInfo = (int*)(smem + 32768);
  int* sPref = sInfo;
  int* sArow = sInfo + 128;
  int* sAsg = sInfo + 256;
  const int t = threadIdx.x;
  const int xg = (gridDim.x >= 8) ? (int)(blockIdx.x & 7) : 0;
  const int ngrp = (gridDim.x >= 8) ? 8 : 1;
  const int lb = (gridDim.x >= 8) ? (int)(blockIdx.x >> 3) : (int)blockIdx.x;
  const int nlb = (gridDim.x >= 8) ? (int)((gridDim.x - xg + 7) >> 3) : (int)gridDim.x;
  const int nex = NEXP / ngrp;
  if (t == 0) {
    int acc = 0;
    for (int q = 0; q < nex; q++) { sPref[q] = acc; acc += (p.cnt()[(xg + ngrp * q) * 32] + 127) >> 7; }
    sPref[nex] = acc;
  }
  __syncthreads();
  const int NT = STAGE == 0 ? (DEXP / 64) : (DM / 128);
  const int total = sPref[nex] * NT;
  for (int j = lb; j < total; j += nlb) {
    int nt = j % NT, mg = j / NT;
    int eq = 0;
    for (int q = 0; q < nex; q++) if (sPref[q + 1] <= mg) eq = q + 1;
    int mt = mg - sPref[eq];
    const int e = xg + ngrp * eq;
    int ce = p.cnt()[e * 32];
    if (t < 128) {
      int idx = mt * 128 + t;
      int a = idx < ce ? p.rowlist()[e * SEQ + idx] : -1;
      sAsg[t] = a;
      sArow[t] = a < 0 ? 0 : (STAGE == 0 ? (a >> 1) : a);
    }
    __syncthreads();
    if (STAGE == 0) {
      const float* W1 = p.w1 + (long)e * DM * DEXP + nt * 64;
      const float* W3 = p.w3 + (long)e * DM * DEXP + nt * 64;
      u16* hidp = p.hid() + nt * 64;
      gemm_tile_wf32(p.hb(), DM, sArow,
                [&](int& k, int& v, const float*& src) {
                  int which = (t >> 4) & 1;
                  k = t >> 5;
                  int c4 = (t & 15) * 4;
                  v = (c4 >> 4) * 32 + which * 16 + (c4 & 15);
                  src = (which ? W3 : W1) + (long)k * DEXP + c4;
                }, DEXP, DM, smem,
                [&](int m, int nb, f32x4 (&a)[4]) {
                  int as = sAsg[m];
                  if (as >= 0) {
                    int wc = nb >> 6, f4 = nb & 63;
#pragma unroll
                    for (int q = 0; q < 2; q++) {
                      f32x4 g = a[2 * q], u = a[2 * q + 1];
                      float r0 = g[0] / (1.f + __expf(-g[0])) * u[0];
                      float r1 = g[1] / (1.f + __expf(-g[1])) * u[1];
                      float r2 = g[2] / (1.f + __expf(-g[2])) * u[2];
                      float r3 = g[3] / (1.f + __expf(-g[3])) * u[3];
                      store_bf4(hidp + (long)as * DEXP + (wc * 2 + q) * 16 + f4, r0, r1, r2, r3);
                    }
                  }
                });
    } else {
      const float* W2 = p.w2 + (long)e * DEXP * DM + nt * 128;
      u16* yp = p.yslot() + nt * 128;
      const float* gp = p.gates();
      gemm_tile_wf32(p.hid(), DEXP, sArow,
                [&](int& k, int& v, const float*& src) {
                  k = t >> 5;
                  v = (t & 31) * 4;
                  src = W2 + (long)k * DM + v;
                }, DM, DEXP, smem,
                [&](int m, int nb, f32x4 (&a)[4]) {
                  int as = sAsg[m];
                  if (as >= 0) {
                    float gt = gp[as];
#pragma unroll
                    for (int q = 0; q < 4; q++) store_bf4(yp + (long)as * DM + nb + q * 16, gt * a[q][0], gt * a[q][1], gt * a[q][2], gt * a[q][3]);
                  }
                });
    }
    __syncthreads();
  }
}


#define XB_TMO      128
#define XB_XCNT(j)  (256  + 64 * (j))
#define XB_XSUB(j)  (1280 + 64 * (j))
#define XB_XGEN(j)  (2304 + 64 * (j))
#define XB_TOP      3328
#define XB_TOPGEN   3392
#define XCD_BAR_WORDS 3456
#define XB_SPIN_CAP (1u << 22)
__device__ __forceinline__ unsigned xb_ld(unsigned* p) { return __hip_atomic_load(p, __ATOMIC_RELAXED, __HIP_MEMORY_SCOPE_AGENT); }
__device__ __forceinline__ unsigned xb_add(unsigned* p, unsigned v) { return __hip_atomic_fetch_add(p, v, __ATOMIC_RELAXED, __HIP_MEMORY_SCOPE_AGENT); }
__device__ __forceinline__ unsigned xb_xcc_id() { return (unsigned)__builtin_amdgcn_s_getreg((3 << 11) | 20) & 0xFu; }
#define XB_SPIN(cond, bar) do { unsigned _sp = 0; while (cond) { __builtin_amdgcn_s_sleep(1); \
    if ((++_sp & 255u) == 0u) { if (xb_ld(&(bar)[XB_TMO])) break; if (_sp > XB_SPIN_CAP) { atomicAdd(&(bar)[XB_TMO], 1u); break; } } } } while (0)
struct XcdBarrier { unsigned* bar; unsigned x; volatile LAS unsigned* st; };
__device__ __forceinline__ XcdBarrier xcd_barrier_post(unsigned* bar, volatile LAS unsigned* st) {
  XcdBarrier b; b.bar = bar; b.x = xb_xcc_id(); b.st = st;
  if (threadIdx.x == 0) (void)xb_add(&bar[XB_XCNT(b.x)], 1u);
  return b;
}
__device__ __forceinline__ void xcd_barrier_complete(unsigned* bar, unsigned x, unsigned& nloc, unsigned& nx) {
  const unsigned G = gridDim.x;
  unsigned sum, cnt, mine, sp = 0u;
  for (;;) {
    sum = 0u; cnt = 0u; mine = 0u;
#pragma unroll
    for (unsigned j = 0; j < 16; ++j) { const unsigned c = xb_ld(&bar[XB_XCNT(j)]); sum += c; cnt += (c > 0u) ? 1u : 0u; mine = (j == x) ? c : mine; }
    if (sum == G) break;
    __builtin_amdgcn_s_sleep(1);
    if ((++sp & 255u) == 0u) { if (xb_ld(&bar[XB_TMO])) break; if (sp > XB_SPIN_CAP) { atomicAdd(&bar[XB_TMO], 1u); break; } }
  }
  nloc = mine > 0u ? mine : 1u; nx = cnt > 0u ? cnt : 1u;
}
__device__ __forceinline__ void xcd_barrier(const XcdBarrier& b) {
  asm volatile("s_waitcnt vmcnt(0)" ::: "memory");
  __syncthreads();
  if (threadIdx.x == 0) {
    unsigned* bar = b.bar;
    __builtin_amdgcn_s_waitcnt(0);
    unsigned nloc = b.st[0], nx = b.st[1];
    if (nloc == 0u) { xcd_barrier_complete(bar, b.x, nloc, nx); b.st[0] = nloc; b.st[1] = nx; }
    const unsigned old = xb_add(&bar[XB_XSUB(b.x)], 1u);
    const unsigned gen = old / nloc;
    if (old + 1u == (gen + 1u) * nloc) {
      __builtin_amdgcn_fence(__ATOMIC_RELEASE, "agent");
      asm volatile("s_waitcnt vmcnt(0)" ::: "memory");
      const unsigned og = xb_add(&bar[XB_TOP], 1u);
      const unsigned tg = og / nx;
      if (og + 1u == (tg + 1u) * nx) xb_add(&bar[XB_TOPGEN], 1u);
      else XB_SPIN(xb_ld(&bar[XB_TOPGEN]) == tg, bar);
      __builtin_amdgcn_fence(__ATOMIC_ACQUIRE, "agent");
      xb_add(&bar[XB_XGEN(b.x)], 1u);
      asm volatile("s_waitcnt vmcnt(0)" ::: "memory");
    } else {
      XB_SPIN(xb_ld(&bar[XB_XGEN(b.x)]) == gen, bar);
      __builtin_amdgcn_fence(__ATOMIC_ACQUIRE, "agent");
      asm volatile("s_waitcnt vmcnt(0)" ::: "memory");
    }
  }
  __syncthreads();
}

constexpr int NPH = 14;
__device__ __forceinline__ void run_phase(const Params& p, int ph, u16* smem) {
  switch (ph) {
    case 0: phase_convert(p, smem); break;
    case 1: phase_inproj(p, smem); break;
    case 2: phase_mix(p, smem); break;
    case 3: phase_mixout(p, smem); break;
    case 4: memkv_reduce(p); phase_ln<0>(p, smem); break;
    case 5: phase_qproj(p, smem); break;
    case 6: phase_scores(p, smem); break;
    case 7: phase_softmax(p); break;
    case 8: phase_pv(p, smem); break;
    case 9: phase_oproj(p, smem); break;
    case 10: phase_ln2_route(p); break;
    case 11: phase_moe<0>(p, smem); break;
    case 12: phase_moe<1>(p, smem); break;
    case 13: phase_ln<2>(p, smem); break;
  }
}

__global__ void __launch_bounds__(256, 2) mega_kernel(Params p) {
  extern __shared__ __attribute__((aligned(16))) u16 smem[];
  __shared__ uint4 xb_words;
  cg::grid_group grid = cg::this_grid();
  if (threadIdx.x == 0) xb_words = make_uint4(0u, 0u, 0u, 0u);
  __syncthreads();
  const XcdBarrier xb = xcd_barrier_post(p.bar(), (volatile LAS unsigned*)&xb_words);
  if (p.ws == nullptr) grid.sync();
#define GSYNC() xcd_barrier(xb)
#ifdef ONLY_PH
  run_phase(p, ONLY_PH, smem); GSYNC();
  return;
#endif
  run_phase(p, 0, smem); GSYNC();
  run_phase(p, 1, smem); GSYNC();
  run_phase(p, 2, smem); GSYNC();
  run_phase(p, 3, smem); GSYNC();
  run_phase(p, 4, smem); GSYNC();
  run_phase(p, 5, smem); GSYNC();
  run_phase(p, 6, smem); GSYNC();
  run_phase(p, 7, smem); GSYNC();
  run_phase(p, 8, smem); GSYNC();
  run_phase(p, 9, smem); GSYNC();
  run_phase(p, 10, smem); GSYNC();
  run_phase(p, 11, smem); GSYNC();
  run_phase(p, 12, smem); GSYNC();
  run_phase(p, 13, smem);
}

extern "C" void kernel_launch(void* const* d_in, const int* in_sizes, int n_in, void* d_out, int out_size, void* d_ws,
                              size_t ws_size, hipStream_t stream) {
  static int grid_blocks = 0;
  if (!grid_blocks) {
    int dev = 0, cus = 0, per_cu = 0;
    hipGetDevice(&dev);
    hipDeviceGetAttribute(&cus, hipDeviceAttributeMultiprocessorCount, dev);
    hipFuncSetAttribute((const void*)mega_kernel, hipFuncAttributeMaxDynamicSharedMemorySize, LDS_BYTES);
    hipOccupancyMaxActiveBlocksPerMultiprocessor(&per_cu, (const void*)mega_kernel, 256, LDS_BYTES);
    if (per_cu < 1) per_cu = 1;
    if (per_cu > 2) per_cu = 2;
    grid_blocks = cus * per_cu;
  }
  Params p{};
  const float* const* in = (const float* const*)d_in;
  p.x = in[0]; p.mem = in[1]; p.w_in = in[2]; p.gm_ln_g = in[3]; p.gm_ln_b = in[4]; p.gm_w_s = in[5]; p.gm_b_s = in[6];
  p.w_mix_out = in[7]; p.ln1_g = in[8]; p.ln1_b = in[9]; p.mem_w_q = in[10]; p.mem_w_k = in[11]; p.mem_w_v = in[12];
  p.mem_w_o = in[13]; p.ln2_g = in[14]; p.ln2_b = in[15]; p.w_group = in[16]; p.b_group = in[17]; p.w_router = in[18];
  p.b_router = in[19]; p.w1 = in[20]; p.w3 = in[21]; p.w2 = in[22]; p.ln3_g = in[23]; p.ln3_b = in[24];
  p.out = (float*)d_out;
  p.ws = (char*)d_ws;
  if (ws_size < 772 * MB) { fprintf(stderr, "workspace too small: %zu\n", ws_size); return; }
  hipMemsetAsync((char*)d_ws + 754 * MB, 0, XCD_BAR_WORDS * sizeof(unsigned), stream);
  void* args[] = {&p};
  hipError_t e = hipLaunchCooperativeKernel((const void*)mega_kernel, dim3(grid_blocks), dim3(256), args, LDS_BYTES, stream);
  if (e != hipSuccess) fprintf(stderr, "cooperative launch failed: %s (grid %d)\n", hipGetErrorString(e), grid_blocks);
}
```

```cpp
#include <hip/hip_runtime.h>
#include <hip/hip_cooperative_groups.h>
#include <stdint.h>
#include <stdio.h>
namespace cg = cooperative_groups;

typedef unsigned short u16;
using bf16x8 = __attribute__((ext_vector_type(8))) short;
using f32x4 = __attribute__((ext_vector_type(4))) float;
using u32x4 = __attribute__((ext_vector_type(4))) unsigned int;
#define LAS __attribute__((address_space(3)))

constexpr int SEQ = 8192, DM = 2048, INW = 5120, MEML = 256;
constexpr int NEXP = 64, DEXP = 512;
constexpr float DN_ALPHA = 1.189207115002721f;
constexpr float SB_THRESH = 40.f;
constexpr int LDS_BYTES = 73728;
constexpr size_t MB = 1u << 20;

struct Params {
  const float *x, *mem, *w_in, *gm_ln_g, *gm_ln_b, *gm_w_s, *gm_b_s, *w_mix_out, *ln1_g, *ln1_b;
  const float *mem_w_q, *mem_w_k, *mem_w_v, *mem_w_o, *ln2_g, *ln2_b, *w_group, *b_group, *w_router, *b_router;
  const float *w1, *w3, *w2, *ln3_g, *ln3_b;
  float* out;
  char* ws;
#define WSP(T, name, offmb) __device__ __forceinline__ T* name() const { return (T*)(ws + (size_t)(offmb) * MB); }
  WSP(u16, WinT, 0) WSP(u16, WmixT, 20) WSP(u16, WqT, 28) WSP(u16, WkT, 36) WSP(u16, WvT, 44) WSP(u16, WoT, 52)
  WSP(u16, W1T, 60) WSP(u16, W3T, 188) WSP(u16, W2T, 316)
  WSP(u16, xb, 444)
  WSP(float, scores, 444)
  WSP(u16, memb, 476) WSP(u16, kmem, 477) WSP(u16, vmemT, 478)
  WSP(u16, proj, 479)
  WSP(u16, qm, 479)
  WSP(u16, om, 511)
  WSP(u16, yslot, 479)
  WSP(u16, mixcat, 559)
  WSP(u16, Pm, 559)
  WSP(u16, hid, 575)
  WSP(float, pre, 591)
  WSP(float, hf, 655)
  WSP(u16, hb, 719)
  WSP(int, cnt, 751)
  __device__ __forceinline__ float* gates() const { return (float*)(ws + 751 * MB + 65536); }
  WSP(int, rowlist, 752)
  WSP(unsigned, bar, 754)
  WSP(float, wgT, 755)
  WSP(float, kvpart, 756)
  __device__ __forceinline__ float* wrT() const { return (float*)(ws + 755 * MB + 65536); }
};

__device__ __forceinline__ uint32_t pack2(float a, float b);
__device__ __forceinline__ u16 f2bf(float f) { return (u16)(pack2(f, f) & 0xffffu); }
__device__ __forceinline__ float bflo(uint32_t w) { return __uint_as_float(w << 16); }
__device__ __forceinline__ float bfhi(uint32_t w) { return __uint_as_float(w & 0xffff0000u); }
typedef float f32x2_t __attribute__((ext_vector_type(2)));
typedef __bf16 bf16x2_t __attribute__((ext_vector_type(2)));
__device__ __forceinline__ uint32_t pack2(float a, float b) {
  f32x2_t v = {a, b};
  bf16x2_t r = __builtin_convertvector(v, bf16x2_t);
  return __builtin_bit_cast(uint32_t, r);
}
__device__ __forceinline__ float gelu_tanh(float x) {
  float u = 0.7978845608028654f * (x + 0.044715f * x * x * x);
  float e = __expf(2.f * u);
  float th = 1.f - 2.f / (e + 1.f);
  return 0.5f * x * (1.f + th);
}
__device__ __forceinline__ float wave_sum(float v) {
#pragma unroll
  for (int o = 32; o; o >>= 1) v += __shfl_xor(v, o);
  return v;
}
__device__ __forceinline__ float wave_max(float v) {
#pragma unroll
  for (int o = 32; o; o >>= 1) v = fmaxf(v, __shfl_xor(v, o));
  return v;
}
__device__ __forceinline__ void store_bf4(u16* dst, float a, float b, float c, float d) {
  uint2 w; w.x = pack2(a, b); w.y = pack2(c, d);
  *(uint2*)dst = w;
}

__device__ __forceinline__ void mma_128x128x64(const u16* sA, const u16* sB, f32x4 (&acc)[4][4], int wr, int wc, int fr, int fq) {
  bf16x8 af[2][4], bfr[2][4];
#pragma unroll
  for (int ks = 0; ks < 2; ks++) {
#pragma unroll
    for (int mt = 0; mt < 4; mt++) {
      int row = wr * 64 + mt * 16 + fr;
      int ch = (ks * 4 + fq) ^ ((row >> 1) & 7);
      af[ks][mt] = *(const bf16x8*)(sA + row * 64 + ch * 8);
    }
#pragma unroll
    for (int nt = 0; nt < 4; nt++) {
      int row = wc * 64 + nt * 16 + fr;
      int ch = (ks * 4 + fq) ^ ((row >> 1) & 7);
      bfr[ks][nt] = *(const bf16x8*)(sB + row * 64 + ch * 8);
    }
  }
  __builtin_amdgcn_sched_barrier(0);
  __builtin_amdgcn_s_setprio(1);
#pragma unroll
  for (int ks = 0; ks < 2; ks++)
#pragma unroll
    for (int mt = 0; mt < 4; mt++)
#pragma unroll
      for (int nt = 0; nt < 4; nt++)
        acc[mt][nt] = __builtin_amdgcn_mfma_f32_16x16x32_bf16(bfr[ks][nt], af[ks][mt], acc[mt][nt], 0, 0, 0);
  __builtin_amdgcn_s_setprio(0);
}

template <class BP, class Epi>
__device__ __forceinline__ void gemm_tile(const u16* __restrict__ A, long lda, const int* arow, int m0, BP bptr, int K,
                                          u16* smem, Epi epi) {
  const int t = threadIdx.x, lane = t & 63, wid = t >> 6, wr = wid >> 1, wc = wid & 1, fr = lane & 15, fq = lane >> 4;
  const int lr = t >> 3;
  const int gch = ((t & 7) ^ ((t >> 4) & 7)) << 3;
  const u16 *ap0, *ap1, *ap2, *ap3;
  {
    long g0 = arow ? (long)arow[lr] : (long)(m0 + lr);
    long g1 = arow ? (long)arow[lr + 32] : (long)(m0 + lr + 32);
    long g2 = arow ? (long)arow[lr + 64] : (long)(m0 + lr + 64);
    long g3 = arow ? (long)arow[lr + 96] : (long)(m0 + lr + 96);
    ap0 = A + g0 * lda + gch; ap1 = A + g1 * lda + gch; ap2 = A + g2 * lda + gch; ap3 = A + g3 * lda + gch;
  }
  const u16* bp0 = bptr(lr) + gch;
  const u16* bp1 = bptr(lr + 32) + gch;
  const u16* bp2 = bptr(lr + 64) + gch;
  const u16* bp3 = bptr(lr + 96) + gch;
  f32x4 acc[4][4];
#pragma unroll
  for (int i = 0; i < 4; i++)
#pragma unroll
    for (int j = 0; j < 4; j++) acc[i][j] = f32x4{0.f, 0.f, 0.f, 0.f};
#define GLDS(src, dst) __builtin_amdgcn_global_load_lds((const unsigned*)(src), (unsigned*)(dst), 16, 0, 0)
#define STAGE(k0, buf)                                                          \
  {                                                                             \
    u16* dA = smem + (buf) * 16384 + wid * 512;                                 \
    u16* dB = dA + 8192;                                                        \
    GLDS(ap0 + (k0), dA); GLDS(bp0 + (k0), dB);                                 \
    GLDS(ap1 + (k0), dA + 2048); GLDS(bp1 + (k0), dB + 2048);                   \
    GLDS(ap2 + (k0), dA + 4096); GLDS(bp2 + (k0), dB + 4096);                   \
    GLDS(ap3 + (k0), dA + 6144); GLDS(bp3 + (k0), dB + 6144);                   \
  }
  STAGE(0, 0);
  const int nk = K >> 6;
  for (int kt = 0; kt < nk; kt++) {
    asm volatile("s_waitcnt vmcnt(0)" ::: "memory");
    __syncthreads();
    if (kt + 1 < nk) STAGE((kt + 1) << 6, (kt + 1) & 1);
    const u16* sA = smem + (kt & 1) * 16384;
    mma_128x128x64(sA, sA + 8192, acc, wr, wc, fr, fq);
  }
#undef STAGE
#undef GLDS
#pragma unroll
  for (int mt = 0; mt < 4; mt++) epi(wr * 64 + mt * 16 + fr, wc * 64 + fq * 4, acc[mt]);
}

struct TileDesc { const u16* A; const u16* B; int m0; };
template <class Desc, class Epi>
__device__ __forceinline__ void gemm_stream(int total, long lda, long ldb, int K, u16* smem, Desc desc, Epi epi) {
  const int t = threadIdx.x, lane = t & 63, wid = t >> 6, wr = wid >> 1, wc = wid & 1, fr = lane & 15, fq = lane >> 4;
  const int lr = t >> 3;
  const int gch = ((t & 7) ^ ((t >> 4) & 7)) << 3;
  int j = blockIdx.x;
  if (j >= total) return;
  const u16 *ap, *bp;
  const long as32 = 32 * lda, bs32 = 32 * ldb;
#define SETUP(jj)                                                               \
  {                                                                             \
    TileDesc d_ = desc(jj);                                                     \
    ap = d_.A + (long)(d_.m0 + lr) * lda + gch;                                 \
    bp = d_.B + (long)lr * ldb + gch;                                           \
  }
#define GLDS(src, dst) __builtin_amdgcn_global_load_lds((const unsigned*)(src), (unsigned*)(dst), 16, 0, 0)
#define STAGE(k0, buf)                                                          \
  {                                                                             \
    u16* dA = smem + (buf) * 16384 + wid * 512;                                 \
    u16* dB = dA + 8192;                                                        \
    GLDS(ap + (k0), dA); GLDS(bp + (k0), dB);                                   \
    GLDS(ap + as32 + (k0), dA + 2048); GLDS(bp + bs32 + (k0), dB + 2048);       \
    GLDS(ap + 2 * as32 + (k0), dA + 4096); GLDS(bp + 2 * bs32 + (k0), dB + 4096); \
    GLDS(ap + 3 * as32 + (k0), dA + 6144); GLDS(bp + 3 * bs32 + (k0), dB + 6144); \
  }
  SETUP(j);
  STAGE(0, 0);
  const int nk = K >> 6;
  for (;;) {
    f32x4 acc[4][4];
#pragma unroll
    for (int i = 0; i < 4; i++)
#pragma unroll
      for (int q = 0; q < 4; q++) acc[i][q] = f32x4{0.f, 0.f, 0.f, 0.f};
    for (int kt = 0; kt < nk; kt++) {
      asm volatile("s_waitcnt vmcnt(0)" ::: "memory");
      __syncthreads();
      if (kt + 1 < nk) STAGE((kt + 1) << 6, (kt + 1) & 1);
      const u16* sA = smem + (kt & 1) * 16384;
      mma_128x128x64(sA, sA + 8192, acc, wr, wc, fr, fq);
    }
    const int jn = j + gridDim.x;
    const bool has = jn < total;
    if (has) { SETUP(jn); STAGE(0, 0); }
#pragma unroll
    for (int mt = 0; mt < 4; mt++) epi(j, wr * 64 + mt * 16 + fr, wc * 64 + fq * 4, acc[mt]);
    if (!has) break;
    j = jn;
  }
#undef SETUP
#undef STAGE
#undef GLDS
}

typedef short s16x4 __attribute__((ext_vector_type(4)));
__device__ __forceinline__ int wt_off(int k, int ch) { return 256 * k + 16 * (ch ^ (((k & 3) << 2) | ((k >> 2) & 3))); }

template <class WM, class Epi>
__device__ __forceinline__ void gemm_tile_wf32(const u16* __restrict__ A, long lda, const int* arow, WM wmap, long kstride, int K,
                                               u16* smem, Epi epi) {
  const int t = threadIdx.x, lane = t & 63, wid = t >> 6, wr = wid >> 1, wc = wid & 1, fr = lane & 15, fq = lane >> 4;
  const int lr = t >> 3;
  const int gch = ((t & 7) ^ ((t >> 4) & 7)) << 3;
  const unsigned ao0 = (unsigned)(arow[lr] * (int)lda + gch), ao1 = (unsigned)(arow[lr + 32] * (int)lda + gch);
  const unsigned ao2 = (unsigned)(arow[lr + 64] * (int)lda + gch), ao3 = (unsigned)(arow[lr + 96] * (int)lda + gch);
  const float* wp0;
  int woff0, woff1;
  {
    int kw, vw;
    wmap(kw, vw, wp0);
    woff0 = wt_off(kw, vw >> 3) + ((vw >> 2) & 1) * 8;
    woff1 = wt_off(kw + 8, vw >> 3) + ((vw >> 2) & 1) * 8;
  }
  f32x4 acc[4][4];
#pragma unroll
  for (int i = 0; i < 4; i++)
#pragma unroll
    for (int j = 0; j < 4; j++) acc[i][j] = f32x4{0.f, 0.f, 0.f, 0.f};
  f32x4 wr0[8], wr1[8];
#define GLDS(src, dst) __builtin_amdgcn_global_load_lds((const unsigned*)(src), (unsigned*)(dst), 16, 0, 0)
#define STAGE_A(k0, buf)                                                        \
  {                                                                             \
    u16* dA = smem + (buf) * 16384 + wid * 512;                                 \
    const u16* Ak = A + (k0);                                                   \
    GLDS(Ak + ao0, dA); GLDS(Ak + ao1, dA + 2048);                              \
    GLDS(Ak + ao2, dA + 4096); GLDS(Ak + ao3, dA + 6144);                       \
  }
#define LOAD_W(R, k0)                                                           \
  {                                                                             \
    _Pragma("unroll") for (int i = 0; i < 8; i++) R[i] = *(const f32x4*)(wp0 + (long)((k0) + 8 * i) * kstride); \
  }
#define WRITE_W(R, buf)                                                         \
  {                                                                             \
    char* dB = (char*)(smem + (buf) * 16384 + 8192);                            \
    _Pragma("unroll") for (int i = 0; i < 8; i++) {                             \
      uint2 w2; w2.x = pack2(R[i][0], R[i][1]); w2.y = pack2(R[i][2], R[i][3]); \
      *(uint2*)(dB + ((i & 1) ? woff1 : woff0) + 2048 * (i & ~1)) = w2;                                             \
    }                                                                           \
  }
#define COMPUTE(buf)                                                            \
  {                                                                             \
    const u16* sA = smem + (buf) * 16384;                                       \
    const char* sB = (const char*)(sA + 8192);                                  \
    _Pragma("unroll") for (int ks = 0; ks < 2; ks++) {                          \
      bf16x8 af[4], bfr[4];                                                     \
      _Pragma("unroll") for (int mt = 0; mt < 4; mt++) {                        \
        int row = wr * 64 + mt * 16 + fr;                                       \
        int ch = (ks * 4 + fq) ^ ((row >> 1) & 7);                              \
        af[mt] = *(const bf16x8*)(sA + row * 64 + ch * 8);                      \
      }                                                                         \
      _Pragma("unroll") for (int nt = 0; nt < 4; nt++) {                        \
        const int c0 = (wc * 64 + nt * 16) >> 3;                                \
        const int k0_ = ks * 32 + fq * 8 + tq;                                  \
        s16x4 lo = __builtin_amdgcn_ds_read_tr16_b64_v4i16((s16x4 LAS*)(sB + wt_off(k0_, c0 + (tp >> 1)) + 8 * (tp & 1)));     \
        s16x4 hi = __builtin_amdgcn_ds_read_tr16_b64_v4i16((s16x4 LAS*)(sB + wt_off(k0_ + 4, c0 + (tp >> 1)) + 8 * (tp & 1))); \
        bfr[nt] = bf16x8{lo[0], lo[1], lo[2], lo[3], hi[0], hi[1], hi[2], hi[3]}; \
      }                                                                         \
      _Pragma("unroll") for (int mt = 0; mt < 4; mt++)                          \
        _Pragma("unroll") for (int nt = 0; nt < 4; nt++)                        \
          acc[mt][nt] = __builtin_amdgcn_mfma_f32_16x16x32_bf16(bfr[nt], af[mt], acc[mt][nt], 0, 0, 0); \
    }                                                                           \
  }
  const int tq = fr >> 2, tp = fr & 3;
  const int trb = wt_off(fq * 8 + tq, wc * 8 + (tp >> 1)) + 8 * (tp & 1);
  const int nk = K >> 6;
  STAGE_A(0, 0);
  LOAD_W(wr0, 0);
  LOAD_W(wr1, 64);
  WRITE_W(wr0, 0);
  for (int kt = 0; kt < nk; kt += 2) {
    asm volatile("s_waitcnt vmcnt(8)" ::: "memory");
    __syncthreads();
    STAGE_A((kt + 1) << 6, 1);
    if (kt + 2 < nk) LOAD_W(wr0, (kt + 2) << 6);
    COMPUTE(0);
    WRITE_W(wr1, 1);
    if (kt + 2 < nk) { asm volatile("s_waitcnt vmcnt(8)" ::: "memory"); } else { asm volatile("s_waitcnt vmcnt(0)" ::: "memory"); }
    __syncthreads();
    if (kt + 2 < nk) { STAGE_A((kt + 2) << 6, 0); }
    if (kt + 3 < nk) LOAD_W(wr1, (kt + 3) << 6);
    COMPUTE(1);
    if (kt + 2 < nk) WRITE_W(wr0, 0);
  }
#undef STAGE_A
#undef LOAD_W
#undef WRITE_W
#undef COMPUTE
#undef GLDS
#pragma unroll
  for (int mt = 0; mt < 4; mt++) epi(wr * 64 + mt * 16 + fr, wc * 64 + fq * 4, acc[mt]);
}

__device__ __forceinline__ void transpose_tile(const float* __restrict__ src, u16* __restrict__ dst, int R, int C, int tr, int tc, u16* lds) {
  const int t = threadIdx.x;
#pragma unroll
  for (int i = 0; i < 4; i++) {
    int r = (t >> 4) + 16 * i, c4 = (t & 15) * 4;
    float4 v = *(const float4*)(src + (long)(tr * 64 + r) * C + tc * 64 + c4);
    lds[(c4 + 0) * 66 + r] = f2bf(v.x);
    lds[(c4 + 1) * 66 + r] = f2bf(v.y);
    lds[(c4 + 2) * 66 + r] = f2bf(v.z);
    lds[(c4 + 3) * 66 + r] = f2bf(v.w);
  }
  __syncthreads();
  {
    int n = t >> 2, k0 = (t & 3) * 16;
    const uint32_t* s32 = (const uint32_t*)(lds + n * 66 + k0);
    uint4 a, b;
    a.x = s32[0]; a.y = s32[1]; a.z = s32[2]; a.w = s32[3];
    b.x = s32[4]; b.y = s32[5]; b.z = s32[6]; b.w = s32[7];
    u16* d = dst + (long)(tc * 64 + n) * R + tr * 64 + k0;
    *(uint4*)d = a;
    *(uint4*)(d + 8) = b;
  }
  __syncthreads();
}

__device__ void phase_convert(const Params& p, u16* smem) {
  const int nb = gridDim.x, bid = blockIdx.x, t = threadIdx.x;
  if (bid == 0 && t < NEXP) p.cnt()[t * 32] = 0;
  for (int i = bid * 256 + t; i < 9 * 8 * DM; i += nb * 256) {
    int G = i / (8 * DM), rem = i % (8 * DM), e = rem / DM, d = rem % DM;
    if (G == 0) p.wgT()[e * DM + d] = p.w_group[d * 8 + e];
    else p.wrT()[((G - 1) * 8 + e) * DM + d] = p.w_router[((long)(G - 1) * DM + d) * 8 + e];
  }
  {
    const long n4x = (long)SEQ * DM / 4, n4m = (long)MEML * DM / 4;
    for (long i = (long)bid * 256 + t; i < n4x + n4m; i += (long)nb * 256) {
      const float* s; u16* d; long j;
      if (i < n4x) { s = p.x; d = p.xb(); j = i; } else { s = p.mem; d = p.memb(); j = i - n4x; }
      float4 v = *(const float4*)(s + j * 4);
      store_bf4(d + j * 4, v.x, v.y, v.z, v.w);
    }
  }
  const int T_IN = 2560, T_SQ = 1024;
  const int total = T_IN + 5 * T_SQ;
  for (int j = bid; j < total; j += nb) {
    const float* src; u16* dst; int R, C, tl;
    if (j < T_IN) { src = p.w_in; dst = p.WinT(); R = DM; C = INW; tl = j; }
    else {
      int q = (j - T_IN) / T_SQ; tl = (j - T_IN) % T_SQ; R = DM; C = DM;
      src = q == 0 ? p.w_mix_out : q == 1 ? p.mem_w_q : q == 2 ? p.mem_w_k : q == 3 ? p.mem_w_v : p.mem_w_o;
      dst = q == 0 ? p.WmixT() : q == 1 ? p.WqT() : q == 2 ? p.WkT() : q == 3 ? p.WvT() : p.WoT();
    }
    int ntc = C / 64;
    transpose_tile(src, dst, R, C, tl / ntc, tl % ntc, smem);
  }
}

__device__ void phase_inproj(const Params& p, u16* smem) {
  const int MT = SEQ / 128, NT = INW / 128;
  const u16* xb = p.xb(); const u16* WinT = p.WinT(); u16* proj = p.proj();
  gemm_stream(MT * NT, DM, DM, DM, smem,
              [&](int j) { int mt = j % MT, nt = j / MT; TileDesc d; d.A = xb; d.B = WinT + (long)nt * 128 * DM; d.m0 = mt * 128; return d; },
              [&](int j, int m, int nb, f32x4 (&a)[4]) {
                int mt = j % MT, nt = j / MT;
                int seg = nt >> 3;
                u16* outp = proj + (long)(mt * 128 + m) * INW + nt * 128 + nb;
#pragma unroll
                for (int q = 0; q < 4; q++) {
                  float v0 = a[q][0], v1 = a[q][1], v2 = a[q][2], v3 = a[q][3];
                  if (seg < 2) { v0 = gelu_tanh(v0); v1 = gelu_tanh(v1); v2 = gelu_tanh(v2); v3 = gelu_tanh(v3); }
                  else if (seg == 2) { const float sc = 0.08838834764831845f; v0 *= sc; v1 *= sc; v2 *= sc; v3 *= sc; }
                  store_bf4(outp + q * 16, v0, v1, v2, v3);
                }
              });
}

__device__ void memkv_tile(const Params& p, int item, u16* smem) {
  const int jj = item >> 2, kc = item & 3;
  int which = jj / 32, r_ = jj % 32, mt = r_ & 1, nt = r_ >> 1;
  const u16* W = (which == 0 ? p.WkT() : p.WvT()) + (long)nt * 128 * DM + kc * 512;
  float* outp = p.kvpart() + ((long)kc * MEML + mt * 128) * 4096 + which * 2048 + nt * 128;
  gemm_tile(p.memb() + kc * 512, DM, nullptr, mt * 128, [&](int r) { return W + (long)r * DM; }, 512, smem,
            [&](int m, int nb, f32x4 (&a)[4]) {
#pragma unroll
              for (int q = 0; q < 4; q++) *(f32x4*)(outp + (long)m * 4096 + nb + q * 16) = a[q];
            });
  __syncthreads();
}

__device__ void memkv_reduce(const Params& p) {
  const float* part = p.kvpart();
  for (int i = blockIdx.x * 256 + threadIdx.x; i < MEML * 4096 / 4; i += gridDim.x * 256) {
    const int m = i >> 10, n = (i & 1023) * 4;
    f32x4 v = *(const f32x4*)(part + (long)m * 4096 + n);
#pragma unroll
    for (int kc = 1; kc < 4; kc++) v += *(const f32x4*)(part + ((long)kc * MEML + m) * 4096 + n);
    if (n < 2048) store_bf4(p.kmem() + (long)m * DM + n, v[0], v[1], v[2], v[3]);
    else {
#pragma unroll
      for (int e = 0; e < 4; e++) p.vmemT()[(long)(n - 2048 + e) * MEML + m] = f2bf(v[e]);
    }
  }
}

__device__ void gmlp_item(const Params& p, int nb, int g, u16* smem) {
  const int t = threadIdx.x, lane = t & 63, wid = t >> 6, wr = wid >> 1, wc = wid & 1, fr = lane & 15, fq = lane >> 4;
  u16* sA = smem;
  u16* sB = smem + 16384;
#pragma unroll
  for (int i = 0; i < 8; i++) {
    int q = t + 256 * i;
    int tt = q >> 4, sc = q & 15, kt = sc >> 3, c = sc & 7;
    const float* src = p.gm_w_s + ((long)g * 128 + tt) * 128 + sc * 8;
    float4 a = *(const float4*)src, b = *(const float4*)(src + 4);
    bool keep = (tt >> 6) >= kt;
    uint4 w;
    w.x = keep ? pack2(a.x, a.y) : 0u; w.y = keep ? pack2(a.z, a.w) : 0u;
    w.z = keep ? pack2(b.x, b.y) : 0u; w.w = keep ? pack2(b.z, b.w) : 0u;
    *(uint4*)(sA + kt * 8192 + tt * 64 + ((c ^ ((tt >> 1) & 7)) << 3)) = w;
  }
  {
    const int s = t >> 1, half = t & 1;
    const u16* vp = p.proj() + (long)(nb * 128 + s) * INW + 1024 + g * 128 + half * 64;
    float v[64];
#pragma unroll
    for (int i = 0; i < 8; i++) {
      uint4 w = *(const uint4*)(vp + i * 8);
      v[i * 8 + 0] = bflo(w.x); v[i * 8 + 1] = bfhi(w.x); v[i * 8 + 2] = bflo(w.y); v[i * 8 + 3] = bfhi(w.y);
      v[i * 8 + 4] = bflo(w.z); v[i * 8 + 5] = bfhi(w.z); v[i * 8 + 6] = bflo(w.w); v[i * 8 + 7] = bfhi(w.w);
    }
    float sum = 0.f;
#pragma unroll
    for (int i = 0; i < 64; i++) sum += v[i];
    sum += __shfl_xor(sum, 1);
    const float mean = sum * (1.f / 128.f);
    float sq = 0.f;
#pragma unroll
    for (int i = 0; i < 64; i++) { float d = v[i] - mean; sq += d * d; }
    sq += __shfl_xor(sq, 1);
    const float rstd = rsqrtf(sq * (1.f / 128.f) + 1e-5f);
    const int kt = s >> 6, kk = s & 63;
    const float* lg = p.gm_ln_g + g * 128 + half * 64;
    const float* lb = p.gm_ln_b + g * 128 + half * 64;
#pragma unroll
    for (int i = 0; i < 64; i++) {
      int cc = half * 64 + i;
      float val = (v[i] - mean) * rstd * lg[i] + lb[i];
      sB[kt * 8192 + cc * 64 + (((kk >> 3) ^ ((cc >> 1) & 7)) << 3) + (kk & 7)] = f2bf(val);
    }
  }
  __syncthreads();
  f32x4 acc[4][4];
#pragma unroll
  for (int i = 0; i < 4; i++)
#pragma unroll
    for (int j = 0; j < 4; j++) acc[i][j] = f32x4{0.f, 0.f, 0.f, 0.f};
  mma_128x128x64(sA, sB, acc, wr, wc, fr, fq);
  mma_128x128x64(sA + 8192, sB + 8192, acc, wr, wc, fr, fq);
#pragma unroll
  for (int mt = 0; mt < 4; mt++) {
    int m = wr * 64 + mt * 16 + fr;
    float bs = p.gm_b_s[g * 128 + m];
    const u16* up = p.proj() + (long)(nb * 128 + m) * INW + g * 128;
    u16* op = p.mixcat() + (long)(nb * 128 + m) * DM + g * 128;
#pragma unroll
    for (int nt = 0; nt < 4; nt++) {
      int n = wc * 64 + nt * 16 + fq * 4;
      uint2 uw = *(const uint2*)(up + n);
      f32x4 a = acc[mt][nt];
      store_bf4(op + n, bflo(uw.x) * (a[0] + bs), bfhi(uw.x) * (a[1] + bs), bflo(uw.y) * (a[2] + bs), bfhi(uw.y) * (a[3] + bs));
    }
  }
  __syncthreads();
}

__device__ void attn_item(const Params& p, int h, int qt, u16* smem) {
  u16* sK = smem;
  u16* sP = smem;
  u16* sVt = smem + 8192;
  float* sS = (float*)(smem + 16384);
  const int t = threadIdx.x, lane = t & 63, w = t >> 6, fr = lane & 15, fq = lane >> 4;
  const int q0 = qt * 128;
  const u16* Qb = p.proj() + 2048 + h * 128;
  const u16* Kb = p.proj() + 3072 + h * 128;
  const u16* Vb = p.proj() + 4096 + h * 128;
  f32x4 o[2][8];
#pragma unroll
  for (int i = 0; i < 2; i++)
#pragma unroll
    for (int j = 0; j < 8; j++) o[i][j] = f32x4{0.f, 0.f, 0.f, 0.f};
  const int srow = t >> 1, half = t & 1;
  const int qg = q0 + srow;
  float crow = 0.f;
  for (int kb = qt * 2 + 1; kb >= 0; kb--) {
    bf16x8 qf[2][4];
#pragma unroll
    for (int mt = 0; mt < 2; mt++)
#pragma unroll
      for (int ks = 0; ks < 4; ks++)
        qf[mt][ks] = *(const bf16x8*)(Qb + (long)(q0 + w * 32 + mt * 16 + fr) * INW + ks * 32 + fq * 8);
#pragma unroll
    for (int i = 0; i < 4; i++) {
      int idx = t + 256 * i;
      int key = idx >> 4, ch = idx & 15;
      uint4 kv = *(const uint4*)(Kb + (long)(kb * 64 + key) * INW + ch * 8);
      *(uint4*)(sK + key * 128 + ((ch ^ (key & 15)) << 3)) = kv;
      uint4 vv = *(const uint4*)(Vb + (long)(kb * 64 + key) * INW + ch * 8);
      *(uint4*)((char*)sVt + wt_off(key, ch)) = vv;
    }
    __syncthreads();
#pragma unroll
    for (int nt = 0; nt < 4; nt++) {
      f32x4 s0 = f32x4{0.f, 0.f, 0.f, 0.f}, s1 = f32x4{0.f, 0.f, 0.f, 0.f};
      const int krow = nt * 16 + fr;
#pragma unroll
      for (int ks = 0; ks < 4; ks++) {
        bf16x8 kf = *(const bf16x8*)(sK + krow * 128 + (((ks * 4 + fq) ^ (krow & 15)) << 3));
        s0 = __builtin_amdgcn_mfma_f32_16x16x32_bf16(kf, qf[0][ks], s0, 0, 0, 0);
        s1 = __builtin_amdgcn_mfma_f32_16x16x32_bf16(kf, qf[1][ks], s1, 0, 0, 0);
      }
      *(f32x4*)(sS + (w * 32 + fr) * 68 + nt * 16 + fq * 4) = s0;
      *(f32x4*)(sS + (w * 32 + 16 + fr) * 68 + nt * 16 + fq * 4) = s1;
    }
    __syncthreads();
    {
      float z[32];
      float* srp = sS + srow * 68 + half * 32;
#pragma unroll
      for (int j4 = 0; j4 < 8; j4++) {
        f32x4 v = *(const f32x4*)(srp + j4 * 4);
        z[j4 * 4 + 0] = v[0]; z[j4 * 4 + 1] = v[1]; z[j4 * 4 + 2] = v[2]; z[j4 * 4 + 3] = v[3];
      }
      const int kbase = kb * 64 + half * 32;
      float tot = 0.f;
#pragma unroll
      for (int j4 = 0; j4 < 8; j4++) {
        f32x4 sv;
#pragma unroll
        for (int e = 0; e < 4; e++) {
          const int j = j4 * 4 + e;
          bool valid = (kbase + j) < qg;
          float zz = z[j];
          float s = valid ? (fmaxf(zz, 0.f) + __logf(1.f + __expf(-fabsf(zz)))) : 0.f;
          sv[e] = s;
          tot += s;
          z[j] = zz - s;
        }
        *(f32x4*)(srp + j4 * 4) = sv;
      }
      const float ptot = __shfl_xor(tot, 1);
      float c = crow + (half == 0 ? ptot : 0.f);
#pragma unroll
      for (int j4 = 7; j4 >= 0; j4--) {
        f32x4 sv = *(const f32x4*)(srp + j4 * 4);
#pragma unroll
        for (int e = 3; e >= 0; e--) {
          const int j = j4 * 4 + e;
          bool valid = (kbase + j) < qg;
          float a = valid ? __expf(z[j] - c) : 0.f;
          c += sv[e];
          z[j] = a;
        }
      }
      crow += tot + ptot;
#pragma unroll
      for (int q = 0; q < 4; q++) {
        uint4 wv;
        wv.x = pack2(z[q * 8 + 0], z[q * 8 + 1]); wv.y = pack2(z[q * 8 + 2], z[q * 8 + 3]);
        wv.z = pack2(z[q * 8 + 4], z[q * 8 + 5]); wv.w = pack2(z[q * 8 + 6], z[q * 8 + 7]);
        *(uint4*)(sP + srow * 64 + (((half * 4 + q) ^ ((srow >> 1) & 7)) << 3)) = wv;
      }
    }
    const int done = __syncthreads_and(crow > SB_THRESH);
#pragma unroll
    for (int ks = 0; ks < 2; ks++) {
      bf16x8 pf[2];
#pragma unroll
      for (int mt = 0; mt < 2; mt++) {
        int row = w * 32 + mt * 16 + fr;
        pf[mt] = *(const bf16x8*)(sP + row * 64 + (((ks * 4 + fq) ^ ((row >> 1) & 7)) << 3));
      }
#pragma unroll
      for (int nt = 0; nt < 8; nt++) {
        const int vk0 = ks * 32 + fq * 8 + (fr >> 2), vc = nt * 2 + ((fr & 3) >> 1), vb8 = 8 * (fr & 1);
        s16x4 vlo = __builtin_amdgcn_ds_read_tr16_b64_v4i16((s16x4 LAS*)((const char*)sVt + wt_off(vk0, vc) + vb8));
        s16x4 vhi = __builtin_amdgcn_ds_read_tr16_b64_v4i16((s16x4 LAS*)((const char*)sVt + wt_off(vk0 + 4, vc) + vb8));
        bf16x8 vf = bf16x8{vlo[0], vlo[1], vlo[2], vlo[3], vhi[0], vhi[1], vhi[2], vhi[3]};
        o[0][nt] = __builtin_amdgcn_mfma_f32_16x16x32_bf16(vf, pf[0], o[0][nt], 0, 0, 0);
        o[1][nt] = __builtin_amdgcn_mfma_f32_16x16x32_bf16(vf, pf[1], o[1][nt], 0, 0, 0);
      }
    }
    __syncthreads();
    if (done) break;
  }
#pragma unroll
  for (int mt = 0; mt < 2; mt++) {
    u16* op = p.mixcat() + (long)(q0 + w * 32 + mt * 16 + fr) * DM + 1024 + h * 128;
#pragma unroll
    for (int nt = 0; nt < 8; nt++) {
      f32x4 a = o[mt][nt];
      store_bf4(op + nt * 16 + fq * 4, a[0], a[1], a[2], a[3]);
    }
  }
}

__device__ void phase_mix(const Params& p, u16* smem) {
  const int NA = 8 * 64, NG = 64 * 8;
  for (int j = gridDim.x - 1 - blockIdx.x; j < 256; j += gridDim.x) memkv_tile(p, j, smem);
#ifndef NO_ATTN
  for (int j = blockIdx.x; j < NA; j += gridDim.x) { int qt = 63 - (j >> 3), h = j & 7; attn_item(p, h, qt, smem); }
#endif
#ifndef NO_GMLP
  for (int j = blockIdx.x; j < NG; j += gridDim.x) gmlp_item(p, j >> 3, j & 7, smem);
#endif
}

template <bool RES_BF16>
__device__ __forceinline__ void gemm_residual(const u16* A, const u16* WT, const void* res_, float* pre, u16* smem) {
  const int MT = SEQ / 128, NT = DM / 128;
  gemm_stream(MT * NT, DM, DM, DM, smem,
              [&](int j) { int mt = j % MT, nt = j / MT; TileDesc d; d.A = A; d.B = WT + (long)nt * 128 * DM; d.m0 = mt * 128; return d; },
              [&](int j, int m, int nb, f32x4 (&a)[4]) {
                int mt = j % MT, nt = j / MT;
                const long off = (long)(mt * 128 + m) * DM + nt * 128 + nb;
#pragma unroll
                for (int q = 0; q < 4; q++) {
                  float4 xv;
                  if (RES_BF16) {
                    uint2 xw = *(const uint2*)((const u16*)res_ + off + q * 16);
                    xv.x = bflo(xw.x); xv.y = bfhi(xw.x); xv.z = bflo(xw.y); xv.w = bfhi(xw.y);
                  } else {
                    xv = *(const float4*)((const float*)res_ + off + q * 16);
                  }
                  float4 r; r.x = DN_ALPHA * xv.x + a[q][0]; r.y = DN_ALPHA * xv.y + a[q][1]; r.z = DN_ALPHA * xv.z + a[q][2]; r.w = DN_ALPHA * xv.w + a[q][3];
                  *(float4*)(pre + off + q * 16) = r;
                }
              });
}
__device__ void phase_mixout(const Params& p, u16* smem) { gemm_residual<false>(p.mixcat(), p.WmixT(), p.x, p.pre(), smem); }
__device__ void phase_oproj(const Params& p, u16* smem) { gemm_residual<true>(p.om(), p.WoT(), p.hb(), p.pre(), smem); }

__device__ void phase_qproj(const Params& p, u16* smem) {
  const int MT = SEQ / 128, NT = DM / 128;
  const u16* hb = p.hb(); const u16* WqT = p.WqT(); u16* qm = p.qm();
  gemm_stream(MT * NT, DM, DM, DM, smem,
              [&](int j) { int mt = j % MT, nt = j / MT; TileDesc d; d.A = hb; d.B = WqT + (long)nt * 128 * DM; d.m0 = mt * 128; return d; },
              [&](int j, int m, int nb, f32x4 (&a)[4]) {
                int mt = j % MT, nt = j / MT;
                u16* outp = qm + (long)(mt * 128 + m) * DM + nt * 128 + nb;
                const float sc = 0.04419417382415922f;
#pragma unroll
                for (int q = 0; q < 4; q++) store_bf4(outp + q * 16, a[q][0] * sc, a[q][1] * sc, a[q][2] * sc, a[q][3] * sc);
              });
}

__device__ void phase_scores(const Params& p, u16* smem) {
  const int MT = SEQ / 128;
  const u16* qm = p.qm(); const u16* kmem = p.kmem(); float* scores = p.scores();
  gemm_stream(4 * MT * 2, DM, DM, 512, smem,
              [&](int j) { int mt = j % MT, r_ = j / MT, nt = r_ & 1, h = r_ >> 1; TileDesc d; d.A = qm + h * 512; d.B = kmem + (long)nt * 128 * DM + h * 512; d.m0 = mt * 128; return d; },
              [&](int j, int m, int nb, f32x4 (&a)[4]) {
                int mt = j % MT, r_ = j / MT, nt = r_ & 1, h = r_ >> 1;
                float* outp = scores + ((long)h * SEQ + mt * 128 + m) * MEML + nt * 128 + nb;
#pragma unroll
                for (int q = 0; q < 4; q++) {
                  float4 r4; r4.x = a[q][0]; r4.y = a[q][1]; r4.z = a[q][2]; r4.w = a[q][3];
                  *(float4*)(outp + q * 16) = r4;
                }
              });
}

__device__ void phase_softmax(const Params& p) {
  const int wpb = 4, lane = threadIdx.x & 63, wid = threadIdx.x >> 6;
  const int nrows = 4 * SEQ;
  for (int r = blockIdx.x * wpb + wid; r < nrows; r += gridDim.x * wpb) {
    float4 v = *(const float4*)(p.scores() + (long)r * MEML + lane * 4);
    float mx = wave_max(fmaxf(fmaxf(v.x, v.y), fmaxf(v.z, v.w)));
    float e0 = __expf(v.x - mx), e1 = __expf(v.y - mx), e2 = __expf(v.z - mx), e3 = __expf(v.w - mx);
    float inv = 1.f / wave_sum(e0 + e1 + e2 + e3);
    store_bf4(p.Pm() + (long)r * MEML + lane * 4, e0 * inv, e1 * inv, e2 * inv, e3 * inv);
  }
}

__device__ void phase_pv(const Params& p, u16* smem) {
  const int MT = SEQ / 128;
  const u16* Pm = p.Pm(); const u16* vmemT = p.vmemT(); u16* om = p.om();
  gemm_stream(4 * MT * 4, MEML, MEML, MEML, smem,
              [&](int j) { int mt = j % MT, r_ = j / MT, nt = r_ & 3, h = r_ >> 2; TileDesc d; d.A = Pm + (long)h * SEQ * MEML; d.B = vmemT + (long)(h * 512 + nt * 128) * MEML; d.m0 = mt * 128; return d; },
              [&](int j, int m, int nb, f32x4 (&a)[4]) {
                int mt = j % MT, r_ = j / MT, nt = r_ & 3, h = r_ >> 2;
                u16* outp = om + (long)(mt * 128 + m) * DM + h * 512 + nt * 128 + nb;
#pragma unroll
                for (int q = 0; q < 4; q++) store_bf4(outp + q * 16, a[q][0], a[q][1], a[q][2], a[q][3]);
              });
}

__device__ __forceinline__ void ln_stats(const float (&v)[32], float& mean, float& rstd) {
  float s = 0.f;
#pragma unroll
  for (int i = 0; i < 32; i++) s += v[i];
  mean = wave_sum(s) * (1.f / DM);
  float q = 0.f;
#pragma unroll
  for (int i = 0; i < 32; i++) { float d = v[i] - mean; q += d * d; }
  rstd = rsqrtf(wave_sum(q) * (1.f / DM) + 1e-5f);
}

typedef const f32x4 __attribute__((address_space(1)))* g_cv4;
typedef f32x4 __attribute__((address_space(1)))* g_v4;
typedef unsigned int u32x2 __attribute__((ext_vector_type(2)));
typedef const u32x2 __attribute__((address_space(1)))* g_cu2;
typedef u32x2 __attribute__((address_space(1)))* g_u2;
template <class G, class T> __device__ __forceinline__ G opaque_g(T* q) { asm volatile("" : "+v"(q)); return (G)q; }

template <int MODE>
__device__ void phase_ln(const Params& p, u16* smem) {
  const int lane = threadIdx.x & 63, wid = threadIdx.x >> 6;
  const float* gam = MODE == 0 ? p.ln1_g : p.ln3_g;
  const float* bet = MODE == 0 ? p.ln1_b : p.ln3_b;
  for (int rb = (blockIdx.x * 4 + wid) * 2; rb < SEQ; rb += gridDim.x * 8) {
    float v[2][32];
#pragma unroll
    for (int q = 0; q < 2; q++) {
      const int r = rb + q;
      if (MODE == 0) {
        g_cv4 pr = opaque_g<g_cv4>(p.pre() + (long)r * DM + lane * 4);
#pragma unroll
        for (int i = 0; i < 8; i++) {
          f32x4 a = pr[i * 64];
          v[q][i * 4 + 0] = a[0]; v[q][i * 4 + 1] = a[1]; v[q][i * 4 + 2] = a[2]; v[q][i * 4 + 3] = a[3];
        }
      } else {
        g_cu2 ph = opaque_g<g_cu2>(p.hb() + (long)r * DM + lane * 4);
        g_cu2 py0 = opaque_g<g_cu2>(p.yslot() + (long)(2 * r) * DM + lane * 4);
        g_cu2 py1 = opaque_g<g_cu2>(p.yslot() + (long)(2 * r + 1) * DM + lane * 4);
#pragma unroll
        for (int i = 0; i < 8; i++) {
          u32x2 hw = ph[i * 64], y0 = py0[i * 64], y1 = py1[i * 64];
          v[q][i * 4 + 0] = DN_ALPHA * bflo(hw[0]) + (bflo(y0[0]) + bflo(y1[0]));
          v[q][i * 4 + 1] = DN_ALPHA * bfhi(hw[0]) + (bfhi(y0[0]) + bfhi(y1[0]));
          v[q][i * 4 + 2] = DN_ALPHA * bflo(hw[1]) + (bflo(y0[1]) + bflo(y1[1]));
          v[q][i * 4 + 3] = DN_ALPHA * bfhi(hw[1]) + (bfhi(y0[1]) + bfhi(y1[1]));
        }
      }
    }
    float mean[2], rstd[2];
    ln_stats(v[0], mean[0], rstd[0]);
    ln_stats(v[1], mean[1], rstd[1]);
    g_cv4 pg = opaque_g<g_cv4>(gam + lane * 4);
    g_cv4 pb = opaque_g<g_cv4>(bet + lane * 4);
#pragma unroll
    for (int q = 0; q < 2; q++) {
      g_v4 po = opaque_g<g_v4>(p.out + (long)(rb + q) * DM + lane * 4);
      g_u2 ph = opaque_g<g_u2>(p.hb() + (long)(rb + q) * DM + lane * 4);
#pragma unroll
      for (int i = 0; i < 8; i++) {
        f32x4 g = pg[i * 64], b = pb[i * 64];
        f32x4 o4;
#pragma unroll
        for (int e = 0; e < 4; e++) o4[e] = (v[q][i * 4 + e] - mean[q]) * rstd[q] * g[e] + b[e];
        if (MODE == 2) po[i * 64] = o4;
        else { u32x2 w = {pack2(o4[0], o4[1]), pack2(o4[2], o4[3])}; ph[i * 64] = w; }
      }
    }
  }
}

typedef const f32x4 __attribute__((address_space(1)))* gv4p;
__device__ __forceinline__ gv4p launder_g(const float* q) { asm volatile("" : "+v"(q)); return (gv4p)q; }

__device__ __forceinline__ void wave_reduce8(float (&a)[8], int lane) {
  float b[4], c[2], d;
  const bool h5 = lane & 32, h4 = lane & 16, h3 = lane & 8;
#pragma unroll
  for (int k = 0; k < 4; k++) {
    float send = h5 ? a[k] : a[k + 4];
    float keep = h5 ? a[k + 4] : a[k];
    b[k] = keep + __shfl_xor(send, 32);
  }
#pragma unroll
  for (int k = 0; k < 2; k++) {
    float send = h4 ? b[k] : b[k + 2];
    float keep = h4 ? b[k + 2] : b[k];
    c[k] = keep + __shfl_xor(send, 16);
  }
  {
    float send = h3 ? c[0] : c[1];
    float keep = h3 ? c[1] : c[0];
    d = keep + __shfl_xor(send, 8);
  }
  d += __shfl_xor(d, 4);
  d += __shfl_xor(d, 2);
  d += __shfl_xor(d, 1);
#pragma unroll
  for (int g = 0; g < 8; g++) a[g] = __shfl(d, ((g >> 2) & 1) * 32 + ((g >> 1) & 1) * 16 + (g & 1) * 8);
}

__device__ void phase_ln2_route(const Params& p) {
  const int lane = threadIdx.x & 63, wid = threadIdx.x >> 6;
  const float* wgT = p.wgT();
  const float* wrT = p.wrT();
#define CH(i) ((i) * 256)
  for (int rb = (blockIdx.x * 4 + wid) * 2; rb < SEQ; rb += gridDim.x * 8) {
    float v[2][32];
#pragma unroll
    for (int q = 0; q < 2; q++)
#pragma unroll
      for (int i = 0; i < 8; i++) {
        f32x4 a = *(const f32x4*)(p.pre() + (long)(rb + q) * DM + CH(i) + lane * 4);
        v[q][i * 4 + 0] = a[0]; v[q][i * 4 + 1] = a[1]; v[q][i * 4 + 2] = a[2]; v[q][i * 4 + 3] = a[3];
      }
    float mean[2], rstd[2];
    ln_stats(v[0], mean[0], rstd[0]);
    ln_stats(v[1], mean[1], rstd[1]);
#pragma unroll
    for (int i = 0; i < 8; i++) {
      int c = CH(i) + lane * 4;
      f32x4 g = *(const f32x4*)(p.ln2_g + c), b = *(const f32x4*)(p.ln2_b + c);
#pragma unroll
      for (int q = 0; q < 2; q++) {
        f32x4 o4;
#pragma unroll
        for (int e = 0; e < 4; e++) { o4[e] = (v[q][i * 4 + e] - mean[q]) * rstd[q] * g[e] + b[e]; v[q][i * 4 + e] = o4[e]; }
        store_bf4(p.hb() + (long)(rb + q) * DM + c, o4[0], o4[1], o4[2], o4[3]);
      }
    }
    float lg[2][8];
    {
      f32x4 wb[2][8];
      {
        gv4p wp = launder_g(wgT + lane * 4);
#pragma unroll
        for (int i = 0; i < 8; i++) wb[0][i] = wp[CH(i) >> 2];
      }
#pragma unroll
      for (int g = 0; g < 8; g++) {
        if (g + 1 < 8) {
          gv4p wp = launder_g(wgT + (g + 1) * DM + lane * 4);
#pragma unroll
          for (int i = 0; i < 8; i++) wb[(g + 1) & 1][i] = wp[CH(i) >> 2];
        }
        __builtin_amdgcn_sched_barrier(0);
        float s0 = 0.f, s1 = 0.f;
#pragma unroll
        for (int i = 0; i < 8; i++)
#pragma unroll
          for (int e = 0; e < 4; e++) { s0 += wb[g & 1][i][e] * v[0][i * 4 + e]; s1 += wb[g & 1][i][e] * v[1][i * 4 + e]; }
        lg[0][g] = s0; lg[1][g] = s1;
        __builtin_amdgcn_sched_barrier(0);
      }
    }
    wave_reduce8(lg[0], lane);
    wave_reduce8(lg[1], lane);
    int gi[2]; float gval[2];
#pragma unroll
    for (int q = 0; q < 2; q++) {
#pragma unroll
      for (int g = 0; g < 8; g++) lg[q][g] += p.b_group[g];
      int bi = 0; float gm = lg[q][0];
#pragma unroll
      for (int g = 1; g < 8; g++) if (lg[q][g] > gm) { gm = lg[q][g]; bi = g; }
      float gs = 0.f;
#pragma unroll
      for (int g = 0; g < 8; g++) gs += __expf(lg[q][g] - gm);
      gval[q] = 1.f / gs;
      gi[q] = __builtin_amdgcn_readfirstlane(bi);
    }
    float le[2][8];
    {
      const float* wr0_ = wrT + (long)gi[0] * 8 * DM;
      const float* wr1_ = wrT + (long)gi[1] * 8 * DM;
      f32x4 wb[2][8];
      {
        gv4p wp = launder_g(wr0_ + lane * 4);
#pragma unroll
        for (int i = 0; i < 8; i++) wb[0][i] = wp[CH(i) >> 2];
      }
#pragma unroll
      for (int u = 0; u < 16; u++) {
        if (u + 1 < 16) {
          gv4p wp = launder_g((((u + 1) >> 3) ? wr1_ : wr0_) + ((u + 1) & 7) * DM + lane * 4);
#pragma unroll
          for (int i = 0; i < 8; i++) wb[(u + 1) & 1][i] = wp[CH(i) >> 2];
        }
        __builtin_amdgcn_sched_barrier(0);
        float s0 = 0.f;
#pragma unroll
        for (int i = 0; i < 8; i++)
#pragma unroll
          for (int e = 0; e < 4; e++) s0 += wb[u & 1][i][e] * v[u >> 3][i * 4 + e];
        le[u >> 3][u & 7] = s0;
        __builtin_amdgcn_sched_barrier(0);
      }
    }
    wave_reduce8(le[0], lane);
    wave_reduce8(le[1], lane);
#pragma unroll
    for (int q = 0; q < 2; q++) {
#pragma unroll
      for (int g = 0; g < 8; g++) le[q][g] += p.b_router[gi[q] * 8 + g];
      int i1 = 0; float v1 = le[q][0];
#pragma unroll
      for (int g = 1; g < 8; g++) if (le[q][g] > v1) { v1 = le[q][g]; i1 = g; }
      int i2 = 0; float v2 = -3.0e38f;
#pragma unroll
      for (int g = 0; g < 8; g++) if (g != i1 && le[q][g] > v2) { v2 = le[q][g]; i2 = g; }
      float e2 = __expf(v2 - v1);
      float g1 = gval[q] / (1.f + e2), g2 = gval[q] * e2 / (1.f + e2);
      if (lane == 0) {
        const int r = rb + q;
        int ea = gi[q] * 8 + i1, eb = gi[q] * 8 + i2;
        int pa = atomicAdd(&p.cnt()[ea * 32], 1);
        p.rowlist()[ea * SEQ + pa] = 2 * r;
        p.gates()[2 * r] = g1;
        int pb = atomicAdd(&p.cnt()[eb * 32], 1);
        p.rowlist()[eb * SEQ + pb] = 2 * r + 1;
        p.gates()[2 * r + 1] = g2;
      }
    }
  }
}
#undef CH

template <int STAGE>
__device__ void phase_moe(const Params& p, u16* smem) {
  int* sInfo = (int*)(smem + 32768);
  int* sPref = sInfo;
  int* sArow = sInfo + 128;
  int* sAsg = sInfo + 256;
  const int t = threadIdx.x;
  const int xg = (gridDim.x >= 8) ? (int)(blockIdx.x & 7) : 0;
  const int ngrp = (gridDim.x >= 8) ? 8 : 1;
  const int lb = (gridDim.x >= 8) ? (int)(blockIdx.x >> 3) : (int)blockIdx.x;
  const int nlb = (gridDim.x >= 8) ? (int)((gridDim.x - xg + 7) >> 3) : (int)gridDim.x;
  const int nex = NEXP / ngrp;
  if (t == 0) {
    int acc = 0;
    for (int q = 0; q < nex; q++) { sPref[q] = acc; acc += (p.cnt()[(xg + ngrp * q) * 32] + 127) >> 7; }
    sPref[nex] = acc;
  }
  __syncthreads();
  const int NT = STAGE == 0 ? (DEXP / 64) : (DM / 128);
  const int total = sPref[nex] * NT;
  for (int j = lb; j < total; j += nlb) {
    int nt = j % NT, mg = j / NT;
    int eq = 0;
    for (int q = 0; q < nex; q++) if (sPref[q + 1] <= mg) eq = q + 1;
    int mt = mg - sPref[eq];
    const int e = xg + ngrp * eq;
    int ce = p.cnt()[e * 32];
    if (t < 128) {
      int idx = mt * 128 + t;
      int a = idx < ce ? p.rowlist()[e * SEQ + idx] : -1;
      sAsg[t] = a;
      sArow[t] = a < 0 ? 0 : (STAGE == 0 ? (a >> 1) : a);
    }
    __syncthreads();
    if (STAGE == 0) {
      const float* W1 = p.w1 + (long)e * DM * DEXP + nt * 64;
      const float* W3 = p.w3 + (long)e * DM * DEXP + nt * 64;
      u16* hidp = p.hid() + nt * 64;
      gemm_tile_wf32(p.hb(), DM, sArow,
                [&](int& k, int& v, const float*& src) {
                  int which = (t >> 4) & 1;
                  k = t >> 5;
                  int c4 = (t & 15) * 4;
                  v = (c4 >> 4) * 32 + which * 16 + (c4 & 15);
                  src = (which ? W3 : W1) + (long)k * DEXP + c4;
                }, DEXP, DM, smem,
                [&](int m, int nb, f32x4 (&a)[4]) {
                  int as = sAsg[m];
                  if (as >= 0) {
                    int wc = nb >> 6, f4 = nb & 63;
#pragma unroll
                    for (int q = 0; q < 2; q++) {
                      f32x4 g = a[2 * q], u = a[2 * q + 1];
                      float r0 = g[0] / (1.f + __expf(-g[0])) * u[0];
                      float r1 = g[1] / (1.f + __expf(-g[1])) * u[1];
                      float r2 = g[2] / (1.f + __expf(-g[2])) * u[2];
                      float r3 = g[3] / (1.f + __expf(-g[3])) * u[3];
                      store_bf4(hidp + (long)as * DEXP + (wc * 2 + q) * 16 + f4, r0, r1, r2, r3);
                    }
                  }
                });
    } else {
      const float* W2 = p.w2 + (long)e * DEXP * DM + nt * 128;
      u16* yp = p.yslot() + nt * 128;
      const float* gp = p.gates();
      gemm_tile_wf32(p.hid(), DEXP, sArow,
                [&](int& k, int& v, const float*& src) {
                  k = t >> 5;
                  v = (t & 31) * 4;
                  src = W2 + (long)k * DM + v;
                }, DM, DEXP, smem,
                [&](int m, int nb, f32x4 (&a)[4]) {
                  int as = sAsg[m];
                  if (as >= 0) {
                    float gt = gp[as];
#pragma unroll
                    for (int q = 0; q < 4; q++) store_bf4(yp + (long)as * DM + nb + q * 16, gt * a[q][0], gt * a[q][1], gt * a[q][2], gt * a[q][3]);
                  }
                });
    }
    __syncthreads();
  }
}


#define XB_TMO      128
#define XB_XCNT(j)  (256  + 64 * (j))
#define XB_XSUB(j)  (1280 + 64 * (j))
#define XB_XGEN(j)  (2304 + 64 * (j))
#define XB_TOP      3328
#define XB_TOPGEN   3392
#define XCD_BAR_WORDS 3456
#define XB_SPIN_CAP (1u << 22)
__device__ __forceinline__ unsigned xb_ld(unsigned* p) { return __hip_atomic_load(p, __ATOMIC_RELAXED, __HIP_MEMORY_SCOPE_AGENT); }
__device__ __forceinline__ unsigned xb_add(unsigned* p, unsigned v) { return __hip_atomic_fetch_add(p, v, __ATOMIC_RELAXED, __HIP_MEMORY_SCOPE_AGENT); }
__device__ __forceinline__ unsigned xb_xcc_id() { return (unsigned)__builtin_amdgcn_s_getreg((3 << 11) | 20) & 0xFu; }
#define XB_SPIN(cond, bar) do { unsigned _sp = 0; while (cond) { __builtin_amdgcn_s_sleep(1); \
    if ((++_sp & 255u) == 0u) { if (xb_ld(&(bar)[XB_TMO])) break; if (_sp > XB_SPIN_CAP) { atomicAdd(&(bar)[XB_TMO], 1u); break; } } } } while (0)
struct XcdBarrier { unsigned* bar; unsigned x; volatile LAS unsigned* st; };
__device__ __forceinline__ XcdBarrier xcd_barrier_post(unsigned* bar, volatile LAS unsigned* st) {
  XcdBarrier b; b.bar = bar; b.x = xb_xcc_id(); b.st = st;
  if (threadIdx.x == 0) (void)xb_add(&bar[XB_XCNT(b.x)], 1u);
  return b;
}
__device__ __forceinline__ void xcd_barrier_complete(unsigned* bar, unsigned x, unsigned& nloc, unsigned& nx) {
  const unsigned G = gridDim.x;
  unsigned sum, cnt, mine, sp = 0u;
  for (;;) {
    sum = 0u; cnt = 0u; mine = 0u;
#pragma unroll
    for (unsigned j = 0; j < 16; ++j) { const unsigned c = xb_ld(&bar[XB_XCNT(j)]); sum += c; cnt += (c > 0u) ? 1u : 0u; mine = (j == x) ? c : mine; }
    if (sum == G) break;
    __builtin_amdgcn_s_sleep(1);
    if ((++sp & 255u) == 0u) { if (xb_ld(&bar[XB_TMO])) break; if (sp > XB_SPIN_CAP) { atomicAdd(&bar[XB_TMO], 1u); break; } }
  }
  nloc = mine > 0u ? mine : 1u; nx = cnt > 0u ? cnt : 1u;
}
__device__ __forceinline__ void xcd_barrier(const XcdBarrier& b) {
  asm volatile("s_waitcnt vmcnt(0)" ::: "memory");
  __syncthreads();
  if (threadIdx.x == 0) {
    unsigned* bar = b.bar;
    __builtin_amdgcn_s_waitcnt(0);
    unsigned nloc = b.st[0], nx = b.st[1];
    if (nloc == 0u) { xcd_barrier_complete(bar, b.x, nloc, nx); b.st[0] = nloc; b.st[1] = nx; }
    const unsigned old = xb_add(&bar[XB_XSUB(b.x)], 1u);
    const unsigned gen = old / nloc;
    if (old + 1u == (gen + 1u) * nloc) {
      __builtin_amdgcn_fence(__ATOMIC_RELEASE, "agent");
      asm volatile("s_waitcnt vmcnt(0)" ::: "memory");
      const unsigned og = xb_add(&bar[XB_TOP], 1u);
      const unsigned tg = og / nx;
      if (og + 1u == (tg + 1u) * nx) xb_add(&bar[XB_TOPGEN], 1u);
      else XB_SPIN(xb_ld(&bar[XB_TOPGEN]) == tg, bar);
      __builtin_amdgcn_fence(__ATOMIC_ACQUIRE, "agent");
      xb_add(&bar[XB_XGEN(b.x)], 1u);
      asm volatile("s_waitcnt vmcnt(0)" ::: "memory");
    } else {
      XB_SPIN(xb_ld(&bar[XB_XGEN(b.x)]) == gen, bar);
      __builtin_amdgcn_fence(__ATOMIC_ACQUIRE, "agent");
      asm volatile("s_waitcnt vmcnt(0)" ::: "memory");
    }
  }
  __syncthreads();
}

constexpr int NPH = 14;
__device__ __forceinline__ void run_phase(const Params& p, int ph, u16* smem) {
  switch (ph) {
    case 0: phase_convert(p, smem); break;
    case 1: phase_inproj(p, smem); break;
    case 2: phase_mix(p, smem); break;
    case 3: phase_mixout(p, smem); break;
    case 4: memkv_reduce(p); phase_ln<0>(p, smem); break;
    case 5: phase_qproj(p, smem); break;
    case 6: phase_scores(p, smem); break;
    case 7: phase_softmax(p); break;
    case 8: phase_pv(p, smem); break;
    case 9: phase_oproj(p, smem); break;
    case 10: phase_ln2_route(p); break;
    case 11: phase_moe<0>(p, smem); break;
    case 12: phase_moe<1>(p, smem); break;
    case 13: phase_ln<2>(p, smem); break;
  }
}

__global__ void __launch_bounds__(256, 2) mega_kernel(Params p) {
  extern __shared__ __attribute__((aligned(16))) u16 smem[];
  __shared__ uint4 xb_words;
  cg::grid_group grid = cg::this_grid();
  if (threadIdx.x == 0) xb_words = make_uint4(0u, 0u, 0u, 0u);
  __syncthreads();
  const XcdBarrier xb = xcd_barrier_post(p.bar(), (volatile LAS unsigned*)&xb_words);
  if (p.ws == nullptr) grid.sync();
#define GSYNC() xcd_barrier(xb)
#ifdef ONLY_PH
  run_phase(p, ONLY_PH, smem); GSYNC();
  return;
#endif
  run_phase(p, 0, smem); GSYNC();
  run_phase(p, 1, smem); GSYNC();
  run_phase(p, 2, smem); GSYNC();
  run_phase(p, 3, smem); GSYNC();
  run_phase(p, 4, smem); GSYNC();
  run_phase(p, 5, smem); GSYNC();
  run_phase(p, 6, smem); GSYNC();
  run_phase(p, 7, smem); GSYNC();
  run_phase(p, 8, smem); GSYNC();
  run_phase(p, 9, smem); GSYNC();
  run_phase(p, 10, smem); GSYNC();
  run_phase(p, 11, smem); GSYNC();
  run_phase(p, 12, smem); GSYNC();
  run_phase(p, 13, smem);
}

extern "C" void kernel_launch(void* const* d_in, const int* in_sizes, int n_in, void* d_out, int out_size, void* d_ws,
                              size_t ws_size, hipStream_t stream) {
  static int grid_blocks = 0;
  if (!grid_blocks) {
    int dev = 0, cus = 0, per_cu = 0;
    hipGetDevice(&dev);
    hipDeviceGetAttribute(&cus, hipDeviceAttributeMultiprocessorCount, dev);
    hipFuncSetAttribute((const void*)mega_kernel, hipFuncAttributeMaxDynamicSharedMemorySize, LDS_BYTES);
    hipOccupancyMaxActiveBlocksPerMultiprocessor(&per_cu, (const void*)mega_kernel, 256, LDS_BYTES);
    if (per_cu < 1) per_cu = 1;
    if (per_cu > 2) per_cu = 2;
    grid_blocks = cus * per_cu;
  }
  Params p{};
  const float* const* in = (const float* const*)d_in;
  p.x = in[0]; p.mem = in[1]; p.w_in = in[2]; p.gm_ln_g = in[3]; p.gm_ln_b = in[4]; p.gm_w_s = in[5]; p.gm_b_s = in[6];
  p.w_mix_out = in[7]; p.ln1_g = in[8]; p.ln1_b = in[9]; p.mem_w_q = in[10]; p.mem_w_k = in[11]; p.mem_w_v = in[12];
  p.mem_w_o = in[13]; p.ln2_g = in[14]; p.ln2_b = in[15]; p.w_group = in[16]; p.b_group = in[17]; p.w_router = in[18];
  p.b_router = in[19]; p.w1 = in[20]; p.w3 = in[21]; p.w2 = in[22]; p.ln3_g = in[23]; p.ln3_b = in[24];
  p.out = (float*)d_out;
  p.ws = (char*)d_ws;
  if (ws_size < 772 * MB) { fprintf(stderr, "workspace too small: %zu\n", ws_size); return; }
  hipMemsetAsync((char*)d_ws + 754 * MB, 0, XCD_BAR_WORDS * sizeof(unsigned), stream);
  void* args[] = {&p};
  hipError_t e = hipLaunchCooperativeKernel((const void*)mega_kernel, dim3(grid_blocks), dim3(256), args, LDS_BYTES, stream);
  if (e != hipSuccess) fprintf(stderr, "cooperative launch failed: %s (grid %d)\n", hipGetErrorString(e), grid_blocks);
}
```
